# Optimizing an MI355X kernel written in HIP

```python
import math
import jax, jax.numpy as jnp
from jax import lax
import numpy as np

D_MODEL = 1024
BATCH = 2
SEQ = 16384
DEPTH = 1
DEC_BATCH = 32
DEC_SEQ = 16
PAST_LEN = 4096

CHUNK = 64
A_HEADS = 8
A_HEAD_DIM = 64
A_WIDTH = A_HEADS * A_HEAD_DIM
A_PREV_CHUNKS = 8
A_WINDOW = (A_PREV_CHUNKS + 1) * CHUNK
A_REL_MAX = 2 * CHUNK
B_HEADS = 4
B_HEAD_DIM = 64
B_VDIM = 2 * B_HEAD_DIM
B_WIDTH = B_HEADS * B_VDIM
M_TOKENS = 256
M_HEADS = 4
M_HEAD_DIM = D_MODEL // M_HEADS
D_FF = 2816
N_BRANCH = 2
IN_COLS = 3 * A_WIDTH + 3 * B_WIDTH
IN_SPLITS = [A_WIDTH, 2 * A_WIDTH, 3 * A_WIDTH, 3 * A_WIDTH + B_WIDTH, 3 * A_WIDTH + 2 * B_WIDTH]
Q_BLOCK = 128
N_NORMS = 9
NORM_EPS = 1e-6
NEG_INF = -1e30

kernel_name = 'hybrid_stream_encoder_step'


def rmsnorm(x, g):
    x32 = x.astype(jnp.float32)
    y = x32 * lax.rsqrt(jnp.mean(x32 * x32, axis=-1, keepdims=True) + NORM_EPS)
    return (y * g.astype(jnp.float32)).astype(x.dtype)


def swiglu(x, w_up, w_down):
    gate, up = jnp.split(x @ w_up, 2, axis=-1)
    return (jax.nn.silu(gate) * up) @ w_down


def alibi_slopes():
    return jnp.asarray(2.0 ** (-8.0 * np.arange(1, B_HEADS + 1) / B_HEADS), dtype=jnp.float32)


def band_attend(q, k, v, pos_q, pos_k, rel_bias):
    cq = pos_q[:, None] // CHUNK
    ck = pos_k[None, :] // CHUNK
    ok = (pos_k[None, :] >= 0) & (ck <= cq) & (ck >= cq - A_PREV_CHUNKS)
    rel = jnp.clip(pos_q[:, None] - pos_k[None, :], -A_REL_MAX, A_REL_MAX) + A_REL_MAX
    bias = rel_bias.astype(jnp.float32)[:, rel]
    s = jnp.einsum('nqhd,nkhd->nhqk', q, k).astype(jnp.float32) * (A_HEAD_DIM ** -0.5) + bias
    p = jax.nn.softmax(jnp.where(ok, s, NEG_INF), axis=-1).astype(v.dtype)
    return jnp.einsum('nhqk,nkhd->nqhd', p, v)


def band_attn_prompt(q, k, v, rel_bias):
    n, s_len = q.shape[:2]
    nc = s_len // CHUNK
    pad = A_PREV_CHUNKS * CHUNK
    kp = jnp.pad(k, ((0, 0), (pad, 0), (0, 0), (0, 0)))
    vp = jnp.pad(v, ((0, 0), (pad, 0), (0, 0), (0, 0)))
    qc = q.reshape(n, nc, CHUNK, A_HEADS, A_HEAD_DIM).swapaxes(0, 1)

    def one_chunk(args):
        c, qi = args
        kb = lax.dynamic_slice_in_dim(kp, c * CHUNK, A_WINDOW, axis=1)
        vb = lax.dynamic_slice_in_dim(vp, c * CHUNK, A_WINDOW, axis=1)
        pos_q = c * CHUNK + jnp.arange(CHUNK, dtype=jnp.int32)
        pos_k = (c - A_PREV_CHUNKS) * CHUNK + jnp.arange(A_WINDOW, dtype=jnp.int32)
        return band_attend(qi, kb, vb, pos_q, pos_k, rel_bias)

    o = lax.map(one_chunk, (jnp.arange(nc, dtype=jnp.int32), qc))
    return o.swapaxes(0, 1).reshape(n, s_len, A_HEADS, A_HEAD_DIM)


def diff_attend(q, k, v, pos_q, pos_k, lam, subln_g, lam_init):
    ok = (pos_k[None, :] // CHUNK) <= (pos_q[:, None] // CHUNK)
    dist = jnp.abs(pos_q[:, None] - pos_k[None, :]).astype(jnp.float32)
    bias = -alibi_slopes()[:, None, None] * dist
    s = jnp.einsum('nqhcd,nkhcd->nhcqk', q, k).astype(jnp.float32) * (B_HEAD_DIM ** -0.5) + bias[:, None]
    p = jax.nn.softmax(jnp.where(ok, s, NEG_INF), axis=-1)
    w = (p[:, :, 0] - lam * p[:, :, 1]).astype(v.dtype)
    o = jnp.einsum('nhqk,nkhe->nqhe', w, v)
    return rmsnorm(o, subln_g) * (1.0 - lam_init)


def diff_attn_prompt(q, k, v, lam, subln_g, lam_init):
    n, s_len = q.shape[:2]
    nb = s_len // Q_BLOCK
    pos_k = jnp.arange(s_len, dtype=jnp.int32)
    qb = q.reshape(n, nb, Q_BLOCK, B_HEADS, 2, B_HEAD_DIM).swapaxes(0, 1)

    def one_block(args):
        i, qi = args
        pos_q = i * Q_BLOCK + jnp.arange(Q_BLOCK, dtype=jnp.int32)
        return diff_attend(qi, k, v, pos_q, pos_k, lam, subln_g, lam_init)

    o = lax.map(one_block, (jnp.arange(nb, dtype=jnp.int32), qb))
    return o.swapaxes(0, 1).reshape(n, s_len, B_HEADS, B_VDIM)


def mem_kv(mem, g, w_mkv):
    n, m, _ = mem.shape
    k, v = jnp.split(rmsnorm(mem, g) @ w_mkv, 2, axis=-1)
    return k.reshape(n, m, M_HEADS, M_HEAD_DIM), v.reshape(n, m, M_HEADS, M_HEAD_DIM)


def mem_attend(xn, mk, mv, w_mq, w_mo):
    n, t, _ = xn.shape
    q = (xn @ w_mq).reshape(n, t, M_HEADS, M_HEAD_DIM)
    s = jnp.einsum('nqhd,nkhd->nhqk', q, mk).astype(jnp.float32) * (M_HEAD_DIM ** -0.5)
    p = jax.nn.softmax(s, axis=-1).astype(mv.dtype)
    o = jnp.einsum('nhqk,nkhd->nqhd', p, mv).reshape(n, t, D_MODEL)
    return o @ w_mo


def pre_mixer(x, g, up1, down1, w_in, w_gate, b_gate):
    h = x + 0.5 * rmsnorm(swiglu(rmsnorm(x, g[0]), up1, down1), g[1])
    u = rmsnorm(h, g[2])
    n, t, _ = u.shape
    qa, ka, va, qb, kb, vb = jnp.split(u @ w_in, IN_SPLITS, axis=-1)
    qa = qa.reshape(n, t, A_HEADS, A_HEAD_DIM)
    ka = ka.reshape(n, t, A_HEADS, A_HEAD_DIM)
    va = va.reshape(n, t, A_HEADS, A_HEAD_DIM)
    qb = qb.reshape(n, t, B_HEADS, 2, B_HEAD_DIM)
    kb = kb.reshape(n, t, B_HEADS, 2, B_HEAD_DIM)
    vb = vb.reshape(n, t, B_HEADS, B_VDIM)
    gates = jax.nn.sigmoid((u @ w_gate + b_gate).astype(jnp.float32)).astype(u.dtype)
    gates = gates.reshape(n, t, N_BRANCH, D_MODEL)
    return h, gates, qa, ka, va, qb, kb, vb


def post_mixer(h, ya, yb, gates, mk, mv, g, w_br_a, w_br_b, w_out, w_mq, w_mo, up2, down2):
    n, t, _ = h.shape
    merged = (gates[:, :, 0] * (ya.reshape(n, t, A_WIDTH) @ w_br_a)
              + gates[:, :, 1] * (yb.reshape(n, t, B_WIDTH) @ w_br_b))
    h = h + rmsnorm(merged @ w_out, g[3])
    h = h + rmsnorm(mem_attend(rmsnorm(h, g[4]), mk, mv, w_mq, w_mo), g[5])
    return h + 0.5 * rmsnorm(swiglu(rmsnorm(h, g[7]), up2, down2), g[8])


def _normal(k, shape, scale):
    return jax.random.normal(k, shape, jnp.float32) * scale


def setup_inputs(seed: int = 0) -> dict:
    key = jax.random.key(seed)
    ks = jax.random.split(key, 32)
    la = min(A_WINDOW, PAST_LEN)
    d_in = D_MODEL ** -0.5
    return {
        'x_prompt': _normal(ks[0], (BATCH, SEQ, D_MODEL), 1.0),
        'x_sample': _normal(ks[1], (DEC_BATCH, DEC_SEQ, D_MODEL), 1.0),
        'cache_a_k': _normal(ks[2], (DEPTH, DEC_BATCH, la, A_HEADS, A_HEAD_DIM), 1.0),
        'cache_a_v': _normal(ks[3], (DEPTH, DEC_BATCH, la, A_HEADS, A_HEAD_DIM), 1.0),
        'cache_b_k': _normal(ks[4], (DEPTH, DEC_BATCH, PAST_LEN, B_HEADS, 2, B_HEAD_DIM), 1.0),
        'cache_b_v': _normal(ks[5], (DEPTH, DEC_BATCH, PAST_LEN, B_HEADS, B_VDIM), 1.0),
        'cache_mem_k': _normal(ks[6], (DEPTH, DEC_BATCH, M_TOKENS, M_HEADS, M_HEAD_DIM), 1.0),
        'cache_mem_v': _normal(ks[7], (DEPTH, DEC_BATCH, M_TOKENS, M_HEADS, M_HEAD_DIM), 1.0),
        'mem_prompt': _normal(ks[8], (BATCH, M_TOKENS, D_MODEL), 1.0),
        'w_in': _normal(ks[9], (DEPTH, D_MODEL, IN_COLS), d_in),
        'w_gate': _normal(ks[10], (DEPTH, D_MODEL, N_BRANCH * D_MODEL), d_in),
        'b_gate': _normal(ks[11], (DEPTH, N_BRANCH * D_MODEL), 0.1),
        'rel_bias': _normal(ks[12], (DEPTH, A_HEADS, 2 * A_REL_MAX + 1), 0.5),
        'lam_qk': _normal(ks[13], (DEPTH, 4, B_HEAD_DIM), 0.1),
        'subln_g': 1.0 + _normal(ks[14], (DEPTH, B_VDIM), 0.05),
        'w_br_a': _normal(ks[15], (DEPTH, A_WIDTH, D_MODEL), A_WIDTH ** -0.5),
        'w_br_b': _normal(ks[16], (DEPTH, B_WIDTH, D_MODEL), B_WIDTH ** -0.5),
        'w_out': _normal(ks[17], (DEPTH, D_MODEL, D_MODEL), d_in),
        'w_mq': _normal(ks[18], (DEPTH, D_MODEL, D_MODEL), d_in),
        'w_mkv': _normal(ks[19], (DEPTH, D_MODEL, 2 * D_MODEL), d_in),
        'w_mo': _normal(ks[20], (DEPTH, D_MODEL, D_MODEL), d_in),
        'norm_g': 1.0 + _normal(ks[21], (DEPTH, N_NORMS, D_MODEL), 0.05),
        'ffn1_up': _normal(ks[22], (DEPTH, D_MODEL, 2 * D_FF), d_in),
        'ffn1_down': _normal(ks[23], (DEPTH, D_FF, D_MODEL), D_FF ** -0.5),
        'ffn2_up': _normal(ks[24], (DEPTH, D_MODEL, 2 * D_FF), d_in),
        'ffn2_down': _normal(ks[25], (DEPTH, D_FF, D_MODEL), D_FF ** -0.5),
    }


def reference(x_prompt, x_sample, cache_a_k, cache_a_v, cache_b_k, cache_b_v, cache_mem_k, cache_mem_v,
              mem_prompt, w_in, w_gate, b_gate, rel_bias, lam_qk, subln_g, w_br_a, w_br_b, w_out,
              w_mq, w_mkv, w_mo, norm_g, ffn1_up, ffn1_down, ffn2_up, ffn2_down):
    s_len = x_prompt.shape[1]
    t_len = x_sample.shape[1]
    past = cache_b_k.shape[2]
    l_a = cache_a_k.shape[2]
    keep_a = min(A_WINDOW, s_len)
    pos_q_s = past + jnp.arange(t_len, dtype=jnp.int32)
    pos_k_sa = jnp.concatenate([past - l_a + jnp.arange(l_a, dtype=jnp.int32), pos_q_s])
    pos_k_sb = jnp.arange(past + t_len, dtype=jnp.int32)

    xp, xs = x_prompt, x_sample
    ak_p, av_p, bk_p, bv_p, mk_p, mv_p = [], [], [], [], [], []
    ak_s, av_s, bk_s, bv_s = [], [], [], []
    for l in range(DEPTH):
        g = norm_g[l]
        lam_init = 0.8 - 0.6 * math.exp(-0.3 * l)
        lq = lam_qk[l].astype(jnp.float32)
        lam = jnp.exp(jnp.sum(lq[0] * lq[1])) - jnp.exp(jnp.sum(lq[2] * lq[3])) + lam_init

        h, gates, qa, ka, va, qb, kb, vb = pre_mixer(xp, g, ffn1_up[l], ffn1_down[l], w_in[l], w_gate[l], b_gate[l])
        ya = band_attn_prompt(qa, ka, va, rel_bias[l])
        yb = diff_attn_prompt(qb, kb, vb, lam, subln_g[l], lam_init)
        mk, mv = mem_kv(mem_prompt, g[6], w_mkv[l])
        xp = post_mixer(h, ya, yb, gates, mk, mv, g, w_br_a[l], w_br_b[l], w_out[l], w_mq[l], w_mo[l],
                        ffn2_up[l], ffn2_down[l])
        ak_p.append(ka[:, s_len - keep_a:])
        av_p.append(va[:, s_len - keep_a:])
        bk_p.append(kb)
        bv_p.append(vb)
        mk_p.append(mk)
        mv_p.append(mv)

        h, gates, qa, ka, va, qb, kb, vb = pre_mixer(xs, g, ffn1_up[l], ffn1_down[l], w_in[l], w_gate[l], b_gate[l])
        ka_all = jnp.concatenate([cache_a_k[l], ka], axis=1)
        va_all = jnp.concatenate([cache_a_v[l], va], axis=1)
        ya = band_attend(qa, ka_all, va_all, pos_q_s, pos_k_sa, rel_bias[l])
        kb_all = jnp.concatenate([cache_b_k[l], kb], axis=1)
        vb_all = jnp.concatenate([cache_b_v[l], vb], axis=1)
        yb = diff_attend(qb, kb_all, vb_all, pos_q_s, pos_k_sb, lam, subln_g[l], lam_init)
        xs = post_mixer(h, ya, yb, gates, cache_mem_k[l], cache_mem_v[l], g, w_br_a[l], w_br_b[l], w_out[l],
                        w_mq[l], w_mo[l], ffn2_up[l], ffn2_down[l])
        ak_s.append(ka_all[:, ka_all.shape[1] - l_a:])
        av_s.append(va_all[:, va_all.shape[1] - l_a:])
        bk_s.append(kb)
        bv_s.append(vb)

    return (xp, xs,
            jnp.stack(ak_p), jnp.stack(av_p), jnp.stack(bk_p), jnp.stack(bv_p), jnp.stack(mk_p), jnp.stack(mv_p),
            jnp.stack(ak_s), jnp.stack(av_s), jnp.stack(bk_s), jnp.stack(bv_s))
```

```cpp
#include <hip/hip_runtime.h>
#include <hip/hip_cooperative_groups.h>
#include <cstdio>
#include <cstdint>
namespace cg = cooperative_groups;
#ifndef MK_MULTI
#define MK_MULTI 0
#endif
namespace pg8 {
#define PG8_LAS __attribute__((address_space(3)))
typedef unsigned short bf16_t;
typedef short bf16x8 __attribute__((ext_vector_type(8)));
typedef float f32x4 __attribute__((ext_vector_type(4)));
typedef unsigned u32x4 __attribute__((ext_vector_type(4)));
constexpr int BM = 256, BK = 64, HALF = 128, HTB = HALF * BK * 2  , STAGE_BYTES = 8 * HTB, NXCD = 8, WGM = 8;

__host__ __device__ __forceinline__ int lds_byte(int r, int c) { const int st = (r >> 4) * 2 + (c >> 5), rr = r & 15, cc = c & 31, ob = rr * 64 + cc * 2; return st * 1024 + (ob ^ (((ob >> 9) & 1) << 5)); }
__host__ __device__ __forceinline__ void stage_rc(int b, int& R, int& C) { const int st = b / 1024, sb = b % 1024, swz = sb ^ (((sb >> 9) & 1) << 5); R = (st >> 1) * 16 + swz / 64; C = (st & 1) * 32 + (swz % 64) / 2; }
__host__ __device__ __forceinline__ int perm32(int rho) { const int n = rho >> 4, i = rho & 15; return 8 * (i >> 2) + 4 * n + (i & 3); }

struct Unit { int pm, pn; };
struct Gemm { const bf16_t* A; const bf16_t* Bt; int M, N, K; };

struct StaticOrder {
    int nM, nN, nwg, G, c;
    __host__ __device__ void init(int M, int N, int G_, int c_) { nM = M / BM; nN = N / BM; nwg = nM * nN; G = G_; c = c_; }
    __host__ __device__ bool next(int i, Unit& u) const {
        const long L = (long)i * G + c; if (L >= nwg) return false;
        int wgid = (int)L; { const int q = nwg / NXCD, r = nwg % NXCD, xcd = wgid % NXCD, off = wgid / NXCD; wgid = (xcd < r ? xcd * (q + 1) : r * (q + 1) + (xcd - r) * q) + off; }
        const int nig = WGM * nN, gid = wgid / nig, fm = gid * WGM, gsz = (nM - fm) < WGM ? (nM - fm) : WGM;
        u.pm = fm + ((wgid % nig) % gsz); u.pn = (wgid % nig) / gsz; return true;
    }
    __device__ __forceinline__ void a_ready(const Unit&) const {}
    __device__ __forceinline__ void done(const Unit&) const {}
};

__device__ __forceinline__ unsigned cvt_pk_bf16(float lo, float hi) { unsigned r; asm volatile("v_cvt_pk_bf16_f32 %0, %1, %2" : "=v"(r) : "v"(lo), "v"(hi)); return r; }
typedef float f32x2 __attribute__((ext_vector_type(2)));
template <class Epi, class Sched, bool ALIGN_EPI = false, bool SP2 = false>
__device__ __forceinline__ void gemm_phase(PG8_LAS unsigned char* lds, const Gemm g, const Sched& S, const Epi& E) {
    const int tid = threadIdx.x, wid = __builtin_amdgcn_readfirstlane(tid >> 6), lane = tid & 63, wr = wid >> 2, wc = wid & 3, fr = lane & 15, fq = lane >> 4;
    const int K = g.K, nt = K / BK;
    unsigned voffA[2], voffB[2];
#pragma unroll
    for (int i = 0; i < 2; ++i) { int R, C; stage_rc(tid * 16 + i * 8192, R, C); const int Rb = Epi::PERM ? ((R & ~31) + perm32(R & 31)) : R;
        voffA[i] = (unsigned)(R * K + C) * 2u; voffB[i] = (unsigned)(Rb * K + C) * 2u; }
    const size_t kstep = (size_t)(BK * 2);
    const size_t hstep = (size_t)HALF * K * 2;
    const size_t tstep = 2 * hstep;
    const unsigned ldsw = (unsigned)wid * 1024u;
    const int aoff = lds_byte(wr * 64 + fr, fq * 8), boff = lds_byte(wc * 32 + fr, fq * 8);
#define PG8_SA(b, h) (((b) * 2 + (h)) * HTB)
#define PG8_SB(b, h) ((4 + (b) * 2 + (h)) * HTB)
#define PG8_STAGE(bufoff, gbase, voff) do { _Pragma("unroll") for (int _i = 0; _i < 2; ++_i) \
        __builtin_amdgcn_global_load_lds((const unsigned*)((const char*)(gbase) + (voff)[_i]), (PG8_LAS unsigned*)(lds + (bufoff) + ldsw + _i * 8192), 16, 0, 0); } while (0)
#define PG8_LDA(dst, b, h) do { _Pragma("unroll") for (int m = 0; m < 4; ++m) _Pragma("unroll") for (int k = 0; k < 2; ++k) dst[m][k] = *(const PG8_LAS bf16x8*)(lds + PG8_SA(b, h) + aoff + m * 2048 + k * 1024); } while (0)
#define PG8_LDB(dst, b, h) do { _Pragma("unroll") for (int n = 0; n < 2; ++n) _Pragma("unroll") for (int k = 0; k < 2; ++k) dst[n][k] = *(const PG8_LAS bf16x8*)(lds + PG8_SB(b, h) + boff + n * 2048 + k * 1024); } while (0)
#define PG8_MMA(ai, bj, At, Bt) do { __builtin_amdgcn_s_setprio(1); _Pragma("unroll") for (int m = 0; m < 4; ++m) _Pragma("unroll") for (int n = 0; n < 2; ++n) _Pragma("unroll") for (int k = 0; k < 2; ++k) \
        acc[ai][bj][m][n] = __builtin_amdgcn_mfma_f32_16x16x32_bf16(Bt[n][k], At[m][k], acc[ai][bj][m][n], 0, 0, 0); __builtin_amdgcn_s_setprio(0); } while (0)
#define PG8_WAIT_V(n) asm volatile("s_waitcnt vmcnt(" #n ")" ::: "memory")
#define PG8_WAIT_L(n) asm volatile("s_waitcnt lgkmcnt(" #n ")" ::: "memory")
#define PG8_BAR __builtin_amdgcn_s_barrier()
#define PG8_SCHED __builtin_amdgcn_sched_barrier(0)
    Unit cur, nxt; int ui = 0;
    if (!S.next(0, cur)) return;
    f32x4 acc[2][2][4][2];
#pragma unroll
    for (int a = 0; a < 2; ++a)
#pragma unroll
        for (int b = 0; b < 2; ++b)
#pragma unroll
            for (int m = 0; m < 4; ++m)
#pragma unroll
                for (int n = 0; n < 2; ++n) acc[a][b][m][n] = (f32x4){0.f, 0.f, 0.f, 0.f};
    bf16x8 At[4][2], B0[2][2], B1[2][2];
    const char* cA = (const char*)g.A + (size_t)cur.pm * tstep; const char* cB = (const char*)g.Bt + (size_t)cur.pn * tstep;
    S.a_ready(cur);
    if constexpr (SP2) {
        PG8_STAGE(PG8_SB(0, 0), cB, voffB); PG8_STAGE(PG8_SB(0, 1), cB + hstep, voffB); PG8_STAGE(PG8_SA(0, 0), cA, voffA); PG8_STAGE(PG8_SA(0, 1), cA + hstep, voffA);
        if (wr == 1) PG8_BAR;
        PG8_WAIT_V(2); PG8_BAR;
        PG8_STAGE(PG8_SB(1, 0), cB + kstep, voffB); PG8_STAGE(PG8_SA(1, 0), cA + kstep, voffA); PG8_STAGE(PG8_SB(1, 1), cB + hstep + kstep, voffB);
        PG8_WAIT_V(6); PG8_BAR;
    } else {
        PG8_STAGE(PG8_SB(0, 0), cB, voffB); PG8_STAGE(PG8_SA(0, 0), cA, voffA); PG8_STAGE(PG8_SB(0, 1), cB + hstep, voffB); PG8_STAGE(PG8_SA(0, 1), cA + hstep, voffA);
        if (wr == 1) PG8_BAR;
        PG8_WAIT_V(4); PG8_BAR;
        PG8_STAGE(PG8_SB(1, 0), cB + kstep, voffB); PG8_STAGE(PG8_SA(1, 0), cA + kstep, voffA); PG8_STAGE(PG8_SB(1, 1), cB + hstep + kstep, voffB);
        PG8_WAIT_V(6); PG8_BAR;
    }
    for (;;) {
        const bool has_next = S.next(ui + 1, nxt);
        const char* nA = has_next ? (const char*)g.A + (size_t)nxt.pm * tstep : cA; const char* nB = has_next ? (const char*)g.Bt + (size_t)nxt.pn * tstep : cB;
        for (int t = 0; t < nt; t += 2) {
            const bool last = (t == nt - 2);
            const char* a1 = cA + (size_t)(t + 1) * kstep;
            const char* a2 = last ? nA : cA + (size_t)(t + 2) * kstep; const char* b2 = last ? nB : cB + (size_t)(t + 2) * kstep;
            const char* a3 = a2 + kstep; const char* b3 = b2 + kstep;
            if (last && has_next) S.a_ready(nxt);
            if constexpr (SP2) {
            PG8_LDB(B0, 0, 0); PG8_LDB(B1, 0, 1); PG8_SCHED; PG8_LDA(At, 0, 0); PG8_STAGE(PG8_SA(1, 1), a1 + hstep, voffA);
            PG8_WAIT_V(8); PG8_WAIT_L(0); PG8_BAR; PG8_MMA(0, 0, At, B0); PG8_MMA(0, 1, At, B1); PG8_BAR; PG8_SCHED;
            PG8_LDA(At, 0, 1); PG8_STAGE(PG8_SB(0, 0), b2, voffB); PG8_STAGE(PG8_SB(0, 1), b2 + hstep, voffB); PG8_STAGE(PG8_SA(0, 0), a2, voffA);
            PG8_WAIT_V(8); PG8_WAIT_L(0); PG8_BAR; PG8_MMA(1, 0, At, B0); PG8_MMA(1, 1, At, B1); PG8_BAR; PG8_SCHED;
            PG8_LDB(B0, 1, 0); PG8_LDB(B1, 1, 1); PG8_SCHED; PG8_LDA(At, 1, 0); PG8_STAGE(PG8_SA(0, 1), a2 + hstep, voffA);
            PG8_WAIT_V(8); PG8_WAIT_L(0); PG8_BAR; PG8_MMA(0, 0, At, B0); PG8_MMA(0, 1, At, B1); PG8_BAR; PG8_SCHED;
            PG8_LDA(At, 1, 1); PG8_STAGE(PG8_SB(1, 0), b3, voffB); PG8_STAGE(PG8_SB(1, 1), b3 + hstep, voffB); PG8_STAGE(PG8_SA(1, 0), a3, voffA);
            PG8_WAIT_V(8); PG8_WAIT_L(0); PG8_BAR; PG8_MMA(1, 0, At, B0); PG8_MMA(1, 1, At, B1); PG8_BAR; PG8_SCHED;
            } else {
            PG8_LDB(B0, 0, 0); PG8_SCHED; PG8_LDA(At, 0, 0); PG8_STAGE(PG8_SA(1, 1), a1 + hstep, voffA);
            PG8_WAIT_L(8); PG8_BAR; PG8_WAIT_L(0); PG8_MMA(0, 0, At, B0); PG8_BAR; PG8_SCHED;
            PG8_LDB(B1, 0, 1); PG8_STAGE(PG8_SB(0, 0), b2, voffB);
            PG8_BAR; PG8_WAIT_L(0); PG8_MMA(0, 1, At, B1); PG8_BAR;
            PG8_LDA(At, 0, 1); PG8_STAGE(PG8_SA(0, 0), a2, voffA);
            PG8_BAR; PG8_WAIT_L(0); PG8_MMA(1, 0, At, B0); PG8_BAR; PG8_SCHED;
            PG8_STAGE(PG8_SB(0, 1), b2 + hstep, voffB);
            PG8_WAIT_V(6); PG8_BAR; PG8_MMA(1, 1, At, B1); PG8_BAR;
            PG8_LDB(B0, 1, 0); PG8_SCHED; PG8_LDA(At, 1, 0); PG8_STAGE(PG8_SA(0, 1), a2 + hstep, voffA);
            PG8_WAIT_L(8); PG8_BAR; PG8_WAIT_L(0); PG8_MMA(0, 0, At, B0); PG8_BAR; PG8_SCHED;
            PG8_LDB(B1, 1, 1); PG8_STAGE(PG8_SB(1, 0), b3, voffB);
            PG8_BAR; PG8_WAIT_L(0); PG8_MMA(0, 1, At, B1); PG8_BAR;
            PG8_LDA(At, 1, 1); PG8_STAGE(PG8_SA(1, 0), a3, voffA);
            PG8_BAR; PG8_WAIT_L(0); PG8_MMA(1, 0, At, B0); PG8_BAR; PG8_SCHED;
            PG8_STAGE(PG8_SB(1, 1), b3 + hstep, voffB);
            PG8_WAIT_V(6); PG8_BAR; PG8_MMA(1, 1, At, B1); PG8_BAR;
            }
        }
        if constexpr (ALIGN_EPI) { if (wr == 0) PG8_BAR; }
        if constexpr (!Epi::AFTER_DRAIN) { E(acc, cur, wr, wc, fr, fq); S.done(cur); }
        if (!has_next) break;
#pragma unroll
        for (int a = 0; a < 2; ++a)
#pragma unroll
            for (int b = 0; b < 2; ++b)
#pragma unroll
                for (int m = 0; m < 4; ++m)
#pragma unroll
                    for (int n = 0; n < 2; ++n) acc[a][b][m][n] = (f32x4){0.f, 0.f, 0.f, 0.f};
        cur = nxt; cA = nA; cB = nB; ++ui;
        if constexpr (ALIGN_EPI) { if (wr == 1) PG8_BAR; }
    }
    PG8_WAIT_V(0);
    if constexpr (!ALIGN_EPI) { if (wr == 0) PG8_BAR; }
    PG8_BAR;
    if constexpr (Epi::AFTER_DRAIN) { E.fused(acc, cur, wr, wc, fr, fq, lds, wid, lane); S.done(cur); }
#undef PG8_SA
#undef PG8_SB
#undef PG8_STAGE
#undef PG8_LDA
#undef PG8_LDB
#undef PG8_MMA
#undef PG8_WAIT_V
#undef PG8_WAIT_L
#undef PG8_BAR
#undef PG8_SCHED
}
}

#define LAS __attribute__((address_space(3)))
typedef unsigned short bf16_t;
typedef short bf16x8 __attribute__((ext_vector_type(8)));
typedef short s16x4 __attribute__((ext_vector_type(4)));
typedef float f32x4 __attribute__((ext_vector_type(4)));
typedef float f32x16 __attribute__((ext_vector_type(16)));
typedef unsigned u32x4 __attribute__((ext_vector_type(4)));
typedef unsigned u32x2 __attribute__((ext_vector_type(2)));
typedef float f32x2_t __attribute__((ext_vector_type(2))); typedef __bf16 bf16x2_t __attribute__((ext_vector_type(2)));
__device__ __forceinline__ unsigned cvt_pk_bf16(float lo, float hi) { f32x2_t v = {lo, hi}; bf16x2_t b = __builtin_convertvector(v, bf16x2_t); return __builtin_bit_cast(unsigned, b); }

constexpr int DM = 1024, SEQ = 16384, NB = 2, DB = 32, DS = 16, PAST = 4096, LA = 576;
constexpr int MP = NB * SEQ, MS = DB * DS, MT = MP + MS;
constexpr int DFF = 2816, NUP = 2 * DFF, NIN = 3072, NGATE = 2048, NING = NIN + NGATE, MEMT = 256;
constexpr float EPS = 1e-6f, LOG2E = 1.4426950408889634f;
static_assert(MT % 256 == 0, "rows");

constexpr size_t O_YP = 0, O_YS = O_YP + (size_t)MP * DM, O_AKP = O_YS + (size_t)MS * DM, O_AVP = O_AKP + (size_t)NB * LA * 512,
    O_BKP = O_AVP + (size_t)NB * LA * 512, O_BVP = O_BKP + (size_t)MP * 512, O_MKP = O_BVP + (size_t)MP * 512, O_MVP = O_MKP + (size_t)NB * MEMT * DM,
    O_AKS = O_MVP + (size_t)NB * MEMT * DM, O_AVS = O_AKS + (size_t)DB * LA * 512, O_BKS = O_AVS + (size_t)DB * LA * 512, O_BVS = O_BKS + (size_t)MS * 512,
    O_END = O_BVS + (size_t)MS * 512;

constexpr size_t MiB = 1u << 20;
constexpr size_t WS_CTL = 0;
constexpr size_t WS_UP1 = 1 * MiB, WS_DN1 = WS_UP1 + 11 * MiB, WS_ING = WS_DN1 + 6 * MiB, WS_BRA = WS_ING + 10 * MiB, WS_BRB = WS_BRA + 1 * MiB,
    WS_OUT = WS_BRB + 1 * MiB, WS_MQ = WS_OUT + 2 * MiB, WS_MKV = WS_MQ + 2 * MiB, WS_MO = WS_MKV + 4 * MiB, WS_UP2 = WS_MO + 2 * MiB, WS_DN2 = WS_UP2 + 11 * MiB,
    WS_MKB = WS_DN2 + 6 * MiB, WS_MEMN = WS_MKB + 2 * MiB, WS_XN = WS_MEMN + 1 * MiB, WS_ACT = WS_XN + 65 * MiB, WS_DF = WS_ACT + 179 * MiB,
    WS_H = WS_DF + 130 * MiB, WS_QKV = WS_H + 130 * MiB, WS_GATES = WS_QKV + 195 * MiB, WS_YA = WS_GATES + 130 * MiB, WS_YB = WS_YA + 33 * MiB, WS_MKS = WS_YB + 33 * MiB, WS_END = WS_MKS + 32 * MiB;
static_assert(WS_END <= 1024 * MiB, "workspace map");

constexpr int LDS_BYTES = 147456;
constexpr int LDS_QW = 140 * 1024;

struct Args { const float* in[26]; float* out; unsigned char* ws; int ph_lo, ph_hi; };

__device__ __forceinline__ float bf_lo(unsigned u) { return __uint_as_float(u << 16); }
__device__ __forceinline__ float bf_hi(unsigned u) { return __uint_as_float(u & 0xffff0000u); }
__device__ __forceinline__ float wave_sum(float v) {
#pragma unroll
    for (int o = 1; o < 64; o <<= 1) v += __shfl_xor(v, o);
    return v;
}
__device__ __forceinline__ u32x4 pack8(const float* v) {
    u32x4 w; w.x = cvt_pk_bf16(v[0], v[1]); w.y = cvt_pk_bf16(v[2], v[3]); w.z = cvt_pk_bf16(v[4], v[5]); w.w = cvt_pk_bf16(v[6], v[7]); return w;
}

#define EPI_ROWS_BEGIN _Pragma("unroll") for (int ai = 0; ai < 2; ++ai) _Pragma("unroll") for (int m = 0; m < 4; ++m) { const int row = u.pm * 256 + ai * 128 + wr * 64 + m * 16 + fr;
#define EPI_ROWS_END }
#define EPI_V8(bj) float v[8]; { const f32x4 a0 = acc[ai][bj][m][0], a1 = acc[ai][bj][m][1]; v[0] = a0[0]; v[1] = a0[1]; v[2] = a0[2]; v[3] = a0[3]; v[4] = a1[0]; v[5] = a1[1]; v[6] = a1[2]; v[7] = a1[3]; }
typedef const f32x4 (&AccRef)[2][2][4][2];

struct EpiSwiglu {
    static constexpr bool PERM = true, AFTER_DRAIN = false; bf16_t* O;
    __device__ __forceinline__ void operator()(AccRef acc, const pg8::Unit& u, int wr, int wc, int fr, int fq) const {
        const int col = u.pn * 128 + wc * 32 + 8 * fq;
        EPI_ROWS_BEGIN
            float o[8];
#pragma unroll
            for (int n = 0; n < 2; ++n)
#pragma unroll
                for (int i = 0; i < 4; ++i) { const float g = acc[ai][0][m][n][i], up = acc[ai][1][m][n][i];
                    const float sg = g * __builtin_amdgcn_rcpf(1.0f + __builtin_amdgcn_exp2f(-g * LOG2E)); o[n * 4 + i] = sg * up; }
            *(u32x4*)(O + (size_t)row * DFF + col) = pack8(o);
        EPI_ROWS_END
    }
};
struct EpiF32 {
    static constexpr bool PERM = true, AFTER_DRAIN = false; float* O; int ldc;
    __device__ __forceinline__ void operator()(AccRef acc, const pg8::Unit& u, int wr, int wc, int fr, int fq) const {
        EPI_ROWS_BEGIN
#pragma unroll
            for (int bj = 0; bj < 2; ++bj) { float* p = O + (size_t)row * ldc + u.pn * 256 + bj * 128 + wc * 32 + 8 * fq;
                *(f32x4*)p = acc[ai][bj][m][0]; *(f32x4*)(p + 4) = acc[ai][bj][m][1]; }
        EPI_ROWS_END
    }
};
struct EpiBf16 {
    static constexpr bool PERM = true, AFTER_DRAIN = false; bf16_t* O; int ldc;
    __device__ __forceinline__ void operator()(AccRef acc, const pg8::Unit& u, int wr, int wc, int fr, int fq) const {
        EPI_ROWS_BEGIN
#pragma unroll
            for (int bj = 0; bj < 2; ++bj) { EPI_V8(bj); *(u32x4*)(O + (size_t)row * ldc + u.pn * 256 + bj * 128 + wc * 32 + 8 * fq) = pack8(v); }
        EPI_ROWS_END
    }
};
struct EpiBrA {
    static constexpr bool PERM = true, AFTER_DRAIN = false; const bf16_t* G; float* T;
    __device__ __forceinline__ void operator()(AccRef acc, const pg8::Unit& u, int wr, int wc, int fr, int fq) const {
        EPI_ROWS_BEGIN
#pragma unroll
            for (int bj = 0; bj < 2; ++bj) { const int col = u.pn * 256 + bj * 128 + wc * 32 + 8 * fq; EPI_V8(bj);
                const u32x4 g = *(const u32x4*)(G + (size_t)row * NGATE + col);
                f32x4 o0, o1; o0[0] = v[0] * bf_lo(g.x); o0[1] = v[1] * bf_hi(g.x); o0[2] = v[2] * bf_lo(g.y); o0[3] = v[3] * bf_hi(g.y);
                o1[0] = v[4] * bf_lo(g.z); o1[1] = v[5] * bf_hi(g.z); o1[2] = v[6] * bf_lo(g.w); o1[3] = v[7] * bf_hi(g.w);
                float* p = T + (size_t)row * DM + col; *(f32x4*)p = o0; *(f32x4*)(p + 4) = o1; }
        EPI_ROWS_END
    }
};
struct EpiBrB {
    static constexpr bool PERM = true, AFTER_DRAIN = false; const bf16_t* G; const float* T; bf16_t* O;
    __device__ __forceinline__ void operator()(AccRef acc, const pg8::Unit& u, int wr, int wc, int fr, int fq) const {
        EPI_ROWS_BEGIN
#pragma unroll
            for (int bj = 0; bj < 2; ++bj) { const int col = u.pn * 256 + bj * 128 + wc * 32 + 8 * fq; EPI_V8(bj);
                const u32x4 g = *(const u32x4*)(G + (size_t)row * NGATE + DM + col);
                const float* p = T + (size_t)row * DM + col; const f32x4 t0 = *(const f32x4*)p, t1 = *(const f32x4*)(p + 4);
                float o[8]; o[0] = t0[0] + v[0] * bf_lo(g.x); o[1] = t0[1] + v[1] * bf_hi(g.x); o[2] = t0[2] + v[2] * bf_lo(g.y); o[3] = t0[3] + v[3] * bf_hi(g.y);
                o[4] = t1[0] + v[4] * bf_lo(g.z); o[5] = t1[1] + v[5] * bf_hi(g.z); o[6] = t1[2] + v[6] * bf_lo(g.w); o[7] = t1[3] + v[7] * bf_hi(g.w);
                *(u32x4*)(O + (size_t)row * DM + col) = pack8(o); }
        EPI_ROWS_END
    }
};
struct EpiMemKV {
    static constexpr bool PERM = true, AFTER_DRAIN = false; float* out; bf16_t* MKB;
    __device__ __forceinline__ void operator()(AccRef acc, const pg8::Unit& u, int wr, int wc, int fr, int fq) const {
        EPI_ROWS_BEGIN
#pragma unroll
            for (int bj = 0; bj < 2; ++bj) { const int col = u.pn * 256 + bj * 128 + wc * 32 + 8 * fq; EPI_V8(bj);
                float* p = out + (col < DM ? O_MKP + (size_t)row * DM + col : O_MVP + (size_t)row * DM + (col - DM));
                *(f32x4*)p = acc[ai][bj][m][0]; *(f32x4*)(p + 4) = acc[ai][bj][m][1];
                *(u32x4*)(MKB + (size_t)row * 2048 + col) = pack8(v); }
        EPI_ROWS_END
    }
};
struct EpiInGate {
    static constexpr bool PERM = true, AFTER_DRAIN = false; bf16_t* QKV; bf16_t* G; const float* bg; float* out;
    __device__ __forceinline__ void operator()(AccRef acc, const pg8::Unit& u, int wr, int wc, int fr, int fq) const {
        const int region = u.pn >> 1;
        EPI_ROWS_BEGIN
            const bool samp = row >= MP;
#pragma unroll
            for (int bj = 0; bj < 2; ++bj) { const int col = u.pn * 256 + bj * 128 + wc * 32 + 8 * fq; EPI_V8(bj);
                if (u.pn < 12) {
                    *(u32x4*)(QKV + (size_t)row * NIN + col) = pack8(v);
                    const int cc = col - region * 512; float* p = nullptr;
                    if (region == 1 || region == 2) {
                        if (!samp) { const int n = row >> 14, t = row & (SEQ - 1); if (t >= SEQ - LA) p = out + (region == 1 ? O_AKP : O_AVP) + ((size_t)(n * LA + t - (SEQ - LA)) * 512 + cc); }
                        else { const int rs = row - MP, n = rs >> 4, t = rs & 15; p = out + (region == 1 ? O_AKS : O_AVS) + ((size_t)(n * LA + (LA - DS) + t) * 512 + cc); }
                    } else if (region == 4 || region == 5) {
                        p = samp ? out + (region == 4 ? O_BKS : O_BVS) + ((size_t)(row - MP) * 512 + cc) : out + (region == 4 ? O_BKP : O_BVP) + ((size_t)row * 512 + cc);
                    }
                    if (p) { *(f32x4*)p = acc[ai][bj][m][0]; *(f32x4*)(p + 4) = acc[ai][bj][m][1]; }
                } else {
                    const int gc = col - NIN; const f32x4 b0 = *(const f32x4*)(bg + gc), b1 = *(const f32x4*)(bg + gc + 4);
                    float o[8];
#pragma unroll
                    for (int i = 0; i < 8; ++i) { const float z = v[i] + (i < 4 ? b0[i & 3] : b1[i & 3]); o[i] = __builtin_amdgcn_rcpf(1.0f + __builtin_amdgcn_exp2f(-z * LOG2E)); }
                    *(u32x4*)(G + (size_t)row * NGATE + gc) = pack8(o);
                }
            }
        EPI_ROWS_END
    }
};

__device__ __forceinline__ unsigned f2bf(float f) { unsigned u = __builtin_bit_cast(unsigned, f); return (u + 0x7fffu + ((u >> 16) & 1u)) >> 16; }
__device__ __forceinline__ unsigned pk2(float lo, float hi) { return f2bf(lo) | (f2bf(hi) << 16); }
__device__ __forceinline__ int up_row(int n) { return n < DFF ? ((n >> 7) << 8) + (n & 127) : ((((n - DFF) >> 7) << 8) + 128 + ((n - DFF) & 127)); }
template <bool UP> __device__ __forceinline__ void transpose_item(const float* W, int K, int N, bf16_t* WT, int row_off, LAS float* scr, int item, int lane) {
    const int nblk = N / 32, kb = item / nblk, nb = item % nblk, k0 = 64 * kb, n0 = 32 * nb;
#pragma unroll 8
    for (int i = 0; i < 32; ++i) { const int kk = 2 * i + (lane >> 5); scr[kk * 33 + (lane & 31)] = W[(size_t)(k0 + kk) * N + n0 + (lane & 31)]; }
    asm volatile("s_waitcnt lgkmcnt(0)" ::: "memory");
    const int c = lane & 7;
    const int r0 = UP ? up_row(n0) : row_off + n0;
#pragma unroll
    for (int j = 0; j < 4; ++j) { const int n = (lane >> 3) + 8 * j; const LAS float* s = scr + (8 * c) * 33 + n;
        u32x4 o; o.x = pk2(s[0 * 33], s[1 * 33]); o.y = pk2(s[2 * 33], s[3 * 33]); o.z = pk2(s[4 * 33], s[5 * 33]); o.w = pk2(s[6 * 33], s[7 * 33]);
        *(u32x4*)(WT + (size_t)(r0 + n) * K + k0 + 8 * c) = o; }
    asm volatile("s_waitcnt lgkmcnt(0)" ::: "memory");
}
__device__ __forceinline__ void rms_row_to_bf16(const float* xrow, const float* g, bf16_t* orow, int lane) {
    const f32x4* xr = (const f32x4*)xrow + lane; const f32x4* gr = (const f32x4*)g + lane;
    f32x4 v[4]; float s = 0.f;
#pragma unroll
    for (int j = 0; j < 4; ++j) { v[j] = xr[64 * j]; s += (v[j].x * v[j].x + v[j].y * v[j].y) + (v[j].z * v[j].z + v[j].w * v[j].w); }
    const float rstd = 1.0f / sqrtf(wave_sum(s) * (1.f / DM) + EPS);
    u32x2* o8 = (u32x2*)orow + lane;
#pragma unroll
    for (int j = 0; j < 4; ++j) { const f32x4 gg = gr[64 * j]; u32x2 w; w.x = cvt_pk_bf16(v[j].x * rstd * gg.x, v[j].y * rstd * gg.y); w.y = cvt_pk_bf16(v[j].z * rstd * gg.z, v[j].w * rstd * gg.w); o8[64 * j] = w; }
}
template <bool FINAL> __device__ __forceinline__ void res_row(const float* base, const float* d, const float* gres, float coef, float* outp, const float* gnorm, bf16_t* xn, int lane) {
    const f32x4* br = (const f32x4*)base + lane; const f32x4* dr = (const f32x4*)d + lane; const f32x4* gr = (const f32x4*)gres + lane;
    f32x4 dv[4], hv[4]; float s = 0.f;
#pragma unroll
    for (int j = 0; j < 4; ++j) { dv[j] = dr[64 * j]; hv[j] = br[64 * j]; s += (dv[j].x * dv[j].x + dv[j].y * dv[j].y) + (dv[j].z * dv[j].z + dv[j].w * dv[j].w); }
    const float rs = coef / sqrtf(wave_sum(s) * (1.f / DM) + EPS);
    float s2 = 0.f;
#pragma unroll
    for (int j = 0; j < 4; ++j) { const f32x4 gg = gr[64 * j]; hv[j] = hv[j] + dv[j] * gg * rs; s2 += (hv[j].x * hv[j].x + hv[j].y * hv[j].y) + (hv[j].z * hv[j].z + hv[j].w * hv[j].w);
        ((f32x4*)outp + lane)[64 * j] = hv[j]; }
    if (!FINAL) {
        const float rstd = 1.0f / sqrtf(wave_sum(s2) * (1.f / DM) + EPS);
        const f32x4* gn = (const f32x4*)gnorm + lane; u32x2* o8 = (u32x2*)xn + lane;
#pragma unroll
        for (int j = 0; j < 4; ++j) { const f32x4 gg = gn[64 * j]; u32x2 w; w.x = cvt_pk_bf16(hv[j].x * rstd * gg.x, hv[j].y * rstd * gg.y); w.y = cvt_pk_bf16(hv[j].z * rstd * gg.z, hv[j].w * rstd * gg.w); o8[64 * j] = w; }
    }
}

struct AUnit {
    const bf16_t* Q; int ldq; int nq; int qpos0;
    const void* K0; const void* V0; int ld0; int nt0;
    const void* K1; const void* V1; int ld1; int n1;
    int kpos0, tb, te, nkeys, head;
    bf16_t* O; int ldo;
};
template <bool F32> struct Piece;
template <> struct Piece<true> { f32x4 a, b; };
template <> struct Piece<false> { u32x4 a; };
__device__ __forceinline__ void piece_load(Piece<true>& p, const void* base, size_t eoff) { const float* s = (const float*)base + eoff; p.a = *(const f32x4*)s; p.b = *(const f32x4*)(s + 4); }
__device__ __forceinline__ void piece_load(Piece<false>& p, const void* base, size_t eoff) { p.a = *(const u32x4*)((const bf16_t*)base + eoff); }
__device__ __forceinline__ u32x4 piece_bf16(const Piece<true>& p) { u32x4 w; w.x = cvt_pk_bf16(p.a[0], p.a[1]); w.y = cvt_pk_bf16(p.a[2], p.a[3]); w.z = cvt_pk_bf16(p.b[0], p.b[1]); w.w = cvt_pk_bf16(p.b[2], p.b[3]); return w; }
__device__ __forceinline__ u32x4 piece_bf16(const Piece<false>& p) { return p.a; }

template <int MODE, bool F32>
__device__ __forceinline__ void attn_unit(LAS unsigned char* lds, const AUnit& u, const float lam, const float* __restrict__ relb, const float* __restrict__ subg) {
    constexpr int DQK = (MODE == 2) ? 256 : 64, KW = (MODE == 2) ? 256 : 128, DV = (MODE == 0) ? 64 : 128, VW = (MODE == 2) ? 256 : 128;
    constexpr int KSTRB = KW * 2 + 16, VSTRB = 136, VOFFB = 64 * KSTRB;
    constexpr int NKP = KW / 64, NVP = VW / 64, NDB = DV / 32;
    constexpr float SCL = ((MODE == 2) ? 0.0625f : 0.125f) * LOG2E;
    const int tid = threadIdx.x, lane = tid & 63, wid = __builtin_amdgcn_readfirstlane(tid >> 6), r32 = lane & 31, hi = lane >> 5;
    const int qg = wid >> 1, s = wid & 1;
    const int koff = (KW == 2 * DQK) ? s * DQK : 0, voff = (VW == 2 * DV) ? s * DV : 0;
    const bool active = (qg * 32 < u.nq);
    const int qrow = qg * 32 + r32, qrow_c = qrow < u.nq ? qrow : u.nq - 1;
    const bf16_t* qp = u.Q + (size_t)qrow_c * u.ldq + ((MODE == 2) ? 0 : s * 64) + hi * 8;
    bf16x8 qf[4];
    if (MODE != 2) {
#pragma unroll
        for (int d0 = 0; d0 < 4; ++d0) qf[d0] = *(const bf16x8*)(qp + d0 * 16);
    }
    const int pq = u.qpos0 + qrow;
    const int cq = (u.qpos0 + qg * 32) >> 6;
    float slope2 = 0.f; if (MODE == 1) slope2 = __builtin_amdgcn_exp2f(-2.0f * (float)(u.head + 1)) * LOG2E;
    const float* rb = relb + (size_t)(u.head + s) * 257;
    float m_run = -1e30f, l_run = 0.f;
    f32x16 o[NDB];
#pragma unroll
    for (int db = 0; db < NDB; ++db)
#pragma unroll
        for (int r = 0; r < 16; ++r) o[db][r] = 0.f;
    Piece<F32> kr[NKP], vr[NVP];
#define ATT_LOAD(t) do { const int t_ = (t); const bool s0_ = t_ < u.nt0; const void* kb_ = s0_ ? u.K0 : u.K1; const void* vb_ = s0_ ? u.V0 : u.V1; const int ld_ = s0_ ? u.ld0 : u.ld1; \
        const int rb_ = s0_ ? 64 * t_ : 64 * (t_ - u.nt0); const int lim_ = s0_ ? 0x7fffffff : u.n1 - 1; \
        _Pragma("unroll") for (int i_ = 0; i_ < NKP; ++i_) { const int p_ = tid + 512 * i_; int row_ = rb_ + p_ / (KW / 8); row_ = row_ < lim_ ? row_ : lim_; piece_load(kr[i_], kb_, (size_t)row_ * ld_ + (p_ % (KW / 8)) * 8); } \
        _Pragma("unroll") for (int i_ = 0; i_ < NVP; ++i_) { const int w_ = (tid >> 6) + 8 * i_; int row_ = rb_ + 16 * (w_ & 3) + (lane & 15); row_ = row_ < lim_ ? row_ : lim_; piece_load(vr[i_], vb_, (size_t)row_ * ld_ + (4 * (w_ >> 2) + (lane >> 4)) * 8); } } while (0)
    if (u.tb < u.te) ATT_LOAD(u.tb);
    for (int t = u.tb; t < u.te; ++t) {
        __syncthreads();
#pragma unroll
        for (int i = 0; i < NKP; ++i) { const int p = tid + 512 * i; *(LAS u32x4*)(lds + (p / (KW / 8)) * KSTRB + (p % (KW / 8)) * 16) = piece_bf16(kr[i]); }
#pragma unroll
        for (int i = 0; i < NVP; ++i) { const int w = (tid >> 6) + 8 * i; const int row = 16 * (w & 3) + (lane & 15), c8 = 4 * (w >> 2) + (lane >> 4); const u32x4 b = piece_bf16(vr[i]);
            LAS bf16_t* vp = (LAS bf16_t*)(lds + VOFFB + (c8 * 8) * VSTRB) + row;
            vp[0 * (VSTRB / 2)] = (bf16_t)(b.x & 0xffffu); vp[1 * (VSTRB / 2)] = (bf16_t)(b.x >> 16); vp[2 * (VSTRB / 2)] = (bf16_t)(b.y & 0xffffu); vp[3 * (VSTRB / 2)] = (bf16_t)(b.y >> 16);
            vp[4 * (VSTRB / 2)] = (bf16_t)(b.z & 0xffffu); vp[5 * (VSTRB / 2)] = (bf16_t)(b.z >> 16); vp[6 * (VSTRB / 2)] = (bf16_t)(b.w & 0xffffu); vp[7 * (VSTRB / 2)] = (bf16_t)(b.w >> 16); }
        __syncthreads();
        if (t + 1 < u.te) ATT_LOAD(t + 1);
        const int ck = (u.kpos0 + 64 * t) >> 6;
        bool vis = active;
        if (MODE == 0) vis = vis && (ck <= cq) && (ck >= cq - 8);
        if (MODE == 1) vis = vis && (ck <= cq);
        if (vis) {
            f32x16 sA, sB;
#pragma unroll
            for (int r = 0; r < 16; ++r) { sA[r] = 0.f; sB[r] = 0.f; }
            if (MODE != 2) {
#pragma unroll
                for (int d0 = 0; d0 < 4; ++d0) {
                    const bf16x8 ka = *(const LAS bf16x8*)(lds + r32 * KSTRB + (koff + d0 * 16 + hi * 8) * 2);
                    const bf16x8 kb = *(const LAS bf16x8*)(lds + (32 + r32) * KSTRB + (koff + d0 * 16 + hi * 8) * 2);
                    sA = __builtin_amdgcn_mfma_f32_32x32x16_bf16(ka, qf[d0], sA, 0, 0, 0);
                    sB = __builtin_amdgcn_mfma_f32_32x32x16_bf16(kb, qf[d0], sB, 0, 0, 0);
                }
            } else {
#pragma unroll 4
                for (int d0 = 0; d0 < 16; ++d0) {
                    const bf16x8 q = *(const bf16x8*)(qp + d0 * 16);
                    const bf16x8 ka = *(const LAS bf16x8*)(lds + r32 * KSTRB + (koff + d0 * 16 + hi * 8) * 2);
                    const bf16x8 kb = *(const LAS bf16x8*)(lds + (32 + r32) * KSTRB + (koff + d0 * 16 + hi * 8) * 2);
                    sA = __builtin_amdgcn_mfma_f32_32x32x16_bf16(ka, q, sA, 0, 0, 0);
                    sB = __builtin_amdgcn_mfma_f32_32x32x16_bf16(kb, q, sB, 0, 0, 0);
                }
            }
            const int rel0 = pq - (u.kpos0 + 64 * t) - 4 * hi;
            if (MODE == 1) { const float bf = (float)rel0;
#pragma unroll
                for (int r = 0; r < 16; ++r) { const float c = (float)((r & 3) + 8 * (r >> 2));
                    sA[r] = sA[r] * SCL - slope2 * __builtin_fabsf(bf - c); sB[r] = sB[r] * SCL - slope2 * __builtin_fabsf(bf - c - 32.0f); }
            } else if (MODE == 0) {
                const int wmin = (u.qpos0 + qg * 32) - (u.kpos0 + 64 * t + 63);
                if (wmin >= 128) { const float cb = rb[256] * LOG2E;
#pragma unroll
                    for (int r = 0; r < 16; ++r) { sA[r] = sA[r] * SCL + cb; sB[r] = sB[r] * SCL + cb; }
                } else {
#pragma unroll
                    for (int r = 0; r < 16; ++r) { const int c = (r & 3) + 8 * (r >> 2);
                        int ra = rel0 - c, rbb = rel0 - c - 32; ra = ra < -128 ? -128 : (ra > 128 ? 128 : ra); rbb = rbb < -128 ? -128 : (rbb > 128 ? 128 : rbb);
                        sA[r] = sA[r] * SCL + rb[ra + 128] * LOG2E; sB[r] = sB[r] * SCL + rb[rbb + 128] * LOG2E; }
                }
            } else {
#pragma unroll
                for (int r = 0; r < 16; ++r) { sA[r] *= SCL; sB[r] *= SCL; }
            }
            if (64 * (t + 1) > u.nkeys) {
                const int k0 = 64 * t + 4 * hi;
#pragma unroll
                for (int r = 0; r < 16; ++r) { const int c = (r & 3) + 8 * (r >> 2); if (k0 + c >= u.nkeys) sA[r] = -INFINITY; if (k0 + c + 32 >= u.nkeys) sB[r] = -INFINITY; }
            }
            float mx = fmaxf(sA[0], sB[0]);
#pragma unroll
            for (int r = 1; r < 16; ++r) mx = fmaxf(mx, fmaxf(sA[r], sB[r]));
            mx = fmaxf(mx, __shfl_xor(mx, 32));
            const float m_new = fmaxf(m_run, mx);
            const float alpha = __builtin_amdgcn_exp2f(m_run - m_new);
            m_run = m_new;
            float rs = 0.f;
#pragma unroll
            for (int r = 0; r < 16; ++r) { sA[r] = __builtin_amdgcn_exp2f(sA[r] - m_new); sB[r] = __builtin_amdgcn_exp2f(sB[r] - m_new); rs += sA[r] + sB[r]; }
            l_run = l_run * alpha + rs;
#pragma unroll
            for (int db = 0; db < NDB; ++db)
#pragma unroll
                for (int r = 0; r < 16; ++r) o[db][r] *= alpha;
            u32x4 pa0, pa1, pb0, pb1;
            pa0.x = cvt_pk_bf16(sA[0], sA[1]); pa0.y = cvt_pk_bf16(sA[2], sA[3]); pa0.z = cvt_pk_bf16(sA[4], sA[5]); pa0.w = cvt_pk_bf16(sA[6], sA[7]);
            pa1.x = cvt_pk_bf16(sA[8], sA[9]); pa1.y = cvt_pk_bf16(sA[10], sA[11]); pa1.z = cvt_pk_bf16(sA[12], sA[13]); pa1.w = cvt_pk_bf16(sA[14], sA[15]);
            pb0.x = cvt_pk_bf16(sB[0], sB[1]); pb0.y = cvt_pk_bf16(sB[2], sB[3]); pb0.z = cvt_pk_bf16(sB[4], sB[5]); pb0.w = cvt_pk_bf16(sB[6], sB[7]);
            pb1.x = cvt_pk_bf16(sB[8], sB[9]); pb1.y = cvt_pk_bf16(sB[10], sB[11]); pb1.z = cvt_pk_bf16(sB[12], sB[13]); pb1.w = cvt_pk_bf16(sB[14], sB[15]);
#pragma unroll
            for (int db = 0; db < NDB; ++db) {
                const LAS unsigned char* vrow = lds + VOFFB + (voff + db * 32 + r32) * VSTRB + hi * 8;
#define ATT_VF(base) ({ const s16x4 lo_ = *(const LAS s16x4*)(vrow + (base) * 2), hi_ = *(const LAS s16x4*)(vrow + ((base) + 8) * 2); (bf16x8){lo_[0], lo_[1], lo_[2], lo_[3], hi_[0], hi_[1], hi_[2], hi_[3]}; })
                o[db] = __builtin_amdgcn_mfma_f32_32x32x16_bf16(ATT_VF(0), __builtin_bit_cast(bf16x8, pa0), o[db], 0, 0, 0);
                o[db] = __builtin_amdgcn_mfma_f32_32x32x16_bf16(ATT_VF(16), __builtin_bit_cast(bf16x8, pa1), o[db], 0, 0, 0);
                o[db] = __builtin_amdgcn_mfma_f32_32x32x16_bf16(ATT_VF(32), __builtin_bit_cast(bf16x8, pb0), o[db], 0, 0, 0);
                o[db] = __builtin_amdgcn_mfma_f32_32x32x16_bf16(ATT_VF(48), __builtin_bit_cast(bf16x8, pb1), o[db], 0, 0, 0);
#undef ATT_VF
            }
        }
    }
#undef ATT_LOAD
    const float l_tot = l_run + __shfl_xor(l_run, 32);
    const float linv = 1.0f / l_tot;
    if (MODE != 1) {
        if (active && qrow < u.nq) {
            bf16_t* op = u.O + (size_t)qrow * u.ldo + ((MODE == 0) ? s * 64 : s * 128) + 4 * hi;
#pragma unroll
            for (int db = 0; db < NDB; ++db)
#pragma unroll
                for (int g = 0; g < 4; ++g) { u32x2 w; w.x = cvt_pk_bf16(o[db][4 * g] * linv, o[db][4 * g + 1] * linv); w.y = cvt_pk_bf16(o[db][4 * g + 2] * linv, o[db][4 * g + 3] * linv);
                    *(u32x2*)(op + db * 32 + 8 * g) = w; }
        }
    } else {
        __syncthreads();
        LAS float* X = (LAS float*)lds + (size_t)qg * 64 * 64 + lane;
        if (s == 1 && active) {
#pragma unroll
            for (int db = 0; db < NDB; ++db)
#pragma unroll
                for (int r = 0; r < 16; ++r) X[(db * 16 + r) * 64] = o[db][r] * linv;
        }
        __syncthreads();
        if (s == 0 && active) {
            float ss = 0.f;
#pragma unroll
            for (int db = 0; db < NDB; ++db)
#pragma unroll
                for (int r = 0; r < 16; ++r) { const float v = o[db][r] * linv - lam * X[(db * 16 + r) * 64]; o[db][r] = v; ss += v * v; }
            ss += __shfl_xor(ss, 32);
            const float rstd = 0.8f / sqrtf(ss * (1.0f / 128.0f) + EPS);
            if (qrow < u.nq) {
                bf16_t* op = u.O + (size_t)qrow * u.ldo + 4 * hi;
#pragma unroll
                for (int db = 0; db < NDB; ++db)
#pragma unroll
                    for (int g = 0; g < 4; ++g) { const f32x4 sg = *(const f32x4*)(subg + db * 32 + 8 * g + 4 * hi);
                        u32x2 w; w.x = cvt_pk_bf16(o[db][4 * g] * rstd * sg[0], o[db][4 * g + 1] * rstd * sg[1]); w.y = cvt_pk_bf16(o[db][4 * g + 2] * rstd * sg[2], o[db][4 * g + 3] * rstd * sg[3]);
                        *(u32x2*)(op + db * 32 + 8 * g) = w; }
            }
        }
    }
}

__global__ void __launch_bounds__(512, 2) fwd_kernel(Args args) {
    extern __shared__ __attribute__((aligned(16))) unsigned char lds_raw[];
    LAS unsigned char* lds = (LAS unsigned char*)lds_raw;
    cg::grid_group grid = cg::this_grid();
    const int tid = threadIdx.x, lane = tid & 63, wave = __builtin_amdgcn_readfirstlane(tid >> 6);
    const int G = gridDim.x, bx = blockIdx.x;
    const int gw = bx * 8 + wave, NGW = G * 8;
    unsigned char* ws = args.ws; float* out = args.out;
    unsigned* ctl = (unsigned*)(ws + WS_CTL);
    const float* x_p = args.in[0]; const float* x_s = args.in[1];
    const float* cak = args.in[2]; const float* cav = args.in[3]; const float* cbk = args.in[4]; const float* cbv = args.in[5];
    const float* cmk = args.in[6]; const float* cmv = args.in[7]; const float* memp = args.in[8];
    const float* b_gate = args.in[11]; const float* rel_bias = args.in[12]; const float* lam_qk = args.in[13]; const float* subln = args.in[14];
    const float* ng = args.in[21];
    bf16_t* W_UP1 = (bf16_t*)(ws + WS_UP1); bf16_t* W_DN1 = (bf16_t*)(ws + WS_DN1); bf16_t* W_ING = (bf16_t*)(ws + WS_ING); bf16_t* W_BRA = (bf16_t*)(ws + WS_BRA);
    bf16_t* W_BRB = (bf16_t*)(ws + WS_BRB); bf16_t* W_OUT = (bf16_t*)(ws + WS_OUT); bf16_t* W_MQ = (bf16_t*)(ws + WS_MQ); bf16_t* W_MKV = (bf16_t*)(ws + WS_MKV);
    bf16_t* W_MO = (bf16_t*)(ws + WS_MO); bf16_t* W_UP2 = (bf16_t*)(ws + WS_UP2); bf16_t* W_DN2 = (bf16_t*)(ws + WS_DN2);
    bf16_t* MKB = (bf16_t*)(ws + WS_MKB); bf16_t* MEMN = (bf16_t*)(ws + WS_MEMN); bf16_t* XN = (bf16_t*)(ws + WS_XN); bf16_t* ACT = (bf16_t*)(ws + WS_ACT);
    float* DF = (float*)(ws + WS_DF); float* H = (float*)(ws + WS_H); bf16_t* QKV = (bf16_t*)(ws + WS_QKV); bf16_t* GATES = (bf16_t*)(ws + WS_GATES);
    bf16_t* YA = (bf16_t*)(ws + WS_YA); bf16_t* YB = (bf16_t*)(ws + WS_YB); bf16_t* MKS = (bf16_t*)(ws + WS_MKS);
    bf16_t* QM = QKV;
    bf16_t* OM = ACT;

    const int lo = args.ph_lo, hi_ph = args.ph_hi;
#ifndef PH_MASK
#define PH_MASK 0xffffffffu
#endif
#define IN(k) ((((PH_MASK) >> (k)) & 1u) && lo <= (k) && (k) < hi_ph)
#define SEAM(k) do { if (IN(k) && IN((k) + 1)) grid.sync(); } while (0)
#define GEMM_PHASE(EPI, e, Aptr, Bptr, Mrows, Ncols, Kdim, cidx) do { pg8::Gemm g_{(const pg8::bf16_t*)(Aptr), (const pg8::bf16_t*)(Bptr), (Mrows), (Ncols), (Kdim)}; pg8::StaticOrder S_; S_.init((Mrows), (Ncols), G, (cidx)); \
        pg8::gemm_phase<EPI, pg8::StaticOrder, true, true>(lds, g_, S_, e); } while (0)

    if (IN(0)) {
        if (bx == 0 && tid < 64) ctl[tid] = 0u;
        LAS float* scr = (LAS float*)(lds + wave * 16384);
        constexpr int I_UP = 16 * (NUP / 32), I_DN = (DFF / 64) * 32, I_IN = 16 * (NIN / 32), I_GT = 16 * (NGATE / 32), I_BR = 8 * 32, I_SQ = 16 * 32, I_MKV = 16 * 64;
        constexpr int NITEMS = 2 * I_UP + 2 * I_DN + I_IN + I_GT + 2 * I_BR + 3 * I_SQ + I_MKV;
        for (int it = gw; it < NITEMS; it += NGW) {
            int r = it;
            if (r < I_UP) { transpose_item<true>(args.in[22], DM, NUP, W_UP1, 0, scr, r, lane); continue; } r -= I_UP;
            if (r < I_UP) { transpose_item<true>(args.in[24], DM, NUP, W_UP2, 0, scr, r, lane); continue; } r -= I_UP;
            if (r < I_DN) { transpose_item<false>(args.in[23], DFF, DM, W_DN1, 0, scr, r, lane); continue; } r -= I_DN;
            if (r < I_DN) { transpose_item<false>(args.in[25], DFF, DM, W_DN2, 0, scr, r, lane); continue; } r -= I_DN;
            if (r < I_IN) { transpose_item<false>(args.in[9], DM, NIN, W_ING, 0, scr, r, lane); continue; } r -= I_IN;
            if (r < I_GT) { transpose_item<false>(args.in[10], DM, NGATE, W_ING, NIN, scr, r, lane); continue; } r -= I_GT;
            if (r < I_BR) { transpose_item<false>(args.in[15], 512, DM, W_BRA, 0, scr, r, lane); continue; } r -= I_BR;
            if (r < I_BR) { transpose_item<false>(args.in[16], 512, DM, W_BRB, 0, scr, r, lane); continue; } r -= I_BR;
            if (r < I_SQ) { transpose_item<false>(args.in[17], DM, DM, W_OUT, 0, scr, r, lane); continue; } r -= I_SQ;
            if (r < I_SQ) { transpose_item<false>(args.in[18], DM, DM, W_MQ, 0, scr, r, lane); continue; } r -= I_SQ;
            if (r < I_SQ) { transpose_item<false>(args.in[20], DM, DM, W_MO, 0, scr, r, lane); continue; } r -= I_SQ;
            transpose_item<false>(args.in[19], DM, 2 * DM, W_MKV, 0, scr, r, lane);
        }
        for (int m = gw; m < MT + NB * MEMT; m += NGW) {
            if (m < MP) rms_row_to_bf16(x_p + (size_t)m * DM, ng, XN + (size_t)m * DM, lane);
            else if (m < MT) rms_row_to_bf16(x_s + (size_t)(m - MP) * DM, ng, XN + (size_t)m * DM, lane);
            else rms_row_to_bf16(memp + (size_t)(m - MT) * DM, ng + 6 * DM, MEMN + (size_t)(m - MT) * DM, lane);
        }
        for (int r = gw; r < 2 * DB * MEMT; r += NGW) {
            const int which = r / (DB * MEMT), rr = r % (DB * MEMT);
            const f32x4* src = (const f32x4*)((which ? cmv : cmk) + (size_t)rr * DM) + lane; u32x2* dst = (u32x2*)(MKS + (size_t)rr * 2048 + which * DM) + lane;
#pragma unroll
            for (int j = 0; j < 4; ++j) { const f32x4 v = src[64 * j]; u32x2 w; w.x = cvt_pk_bf16(v.x, v.y); w.y = cvt_pk_bf16(v.z, v.w); dst[64 * j] = w; }
        }
        for (int r = gw; r < 2 * DB * (LA - DS); r += NGW) {
            const int which = r / (DB * (LA - DS)), rr = r % (DB * (LA - DS)), n = rr / (LA - DS), j = rr % (LA - DS);
            const f32x4* src = (const f32x4*)((which ? cav : cak) + ((size_t)n * LA + j + DS) * 512) + lane;
            f32x4* dst = (f32x4*)(out + (which ? O_AVS : O_AKS) + ((size_t)n * LA + j) * 512) + lane;
            dst[0] = src[0]; dst[64] = src[64];
        }
    }
    SEAM(0);
    if (IN(1)) {
        { EpiSwiglu e{ACT}; GEMM_PHASE(EpiSwiglu, e, XN, W_UP1, MT, NUP, DM, bx); }
        { EpiMemKV e{out, MKB}; GEMM_PHASE(EpiMemKV, e, MEMN, W_MKV, NB * MEMT, 2 * DM, DM, G - 1 - bx); }
    }
    SEAM(1);
    if (IN(2)) { EpiF32 e{DF, DM}; GEMM_PHASE(EpiF32, e, ACT, W_DN1, MT, DM, DFF, bx); }
    SEAM(2);
    if (IN(3)) {
        for (int m = gw; m < MT; m += NGW) res_row<false>(m < MP ? x_p + (size_t)m * DM : x_s + (size_t)(m - MP) * DM, DF + (size_t)m * DM, ng + 1 * DM, 0.5f, H + (size_t)m * DM, ng + 2 * DM, XN + (size_t)m * DM, lane);
    }
    SEAM(3);
    if (IN(4)) { EpiInGate e{QKV, GATES, b_gate, out}; GEMM_PHASE(EpiInGate, e, XN, W_ING, MT, NING, DM, bx); }
    SEAM(4);
    if (IN(5)) {
        float lam;
        { const float a = lam_qk[lane] * lam_qk[64 + lane], b = lam_qk[128 + lane] * lam_qk[192 + lane]; lam = expf(wave_sum(a)) - expf(wave_sum(b)) + 0.2f; }
        constexpr int N_SD = DB * 4, N_PD = NB * 4 * 128, N_PB = NB * 4 * 128, N_SB = DB * 4, N_ALL = N_SD + N_PD + N_PB + N_SB;
        volatile LAS unsigned* qw = (volatile LAS unsigned*)(lds + LDS_QW);
        for (;;) {
            __syncthreads();
            if (tid == 0) qw[0] = atomicAdd(&ctl[0], 1u);
            __syncthreads();
            int idx = (int)qw[0];
            if (idx >= N_ALL) break;
            AUnit u;
            if (idx < N_SD) {
                const int n = idx >> 2, h = idx & 3; const size_t row0 = MP + (size_t)n * DS;
                u.Q = QKV + row0 * NIN + 1536 + h * 128; u.ldq = NIN; u.nq = DS; u.qpos0 = PAST;
                u.K0 = cbk + (size_t)n * PAST * 512 + h * 128; u.V0 = cbv + (size_t)n * PAST * 512 + h * 128; u.ld0 = 512; u.nt0 = PAST / 64;
                u.K1 = out + O_BKS + (size_t)n * DS * 512 + h * 128; u.V1 = out + O_BVS + (size_t)n * DS * 512 + h * 128; u.ld1 = 512; u.n1 = DS;
                u.kpos0 = 0; u.tb = 0; u.te = PAST / 64 + 1; u.nkeys = PAST + DS; u.head = h; u.O = YB + row0 * 512 + h * 128; u.ldo = 512;
                attn_unit<1, true>(lds, u, lam, rel_bias, subln);
            } else if (idx < N_SD + N_PD) {
                const int j = idx - N_SD, qb = 127 - (j >> 3), n = (j >> 2) & 1, h = j & 3; const size_t row0 = (size_t)n * SEQ + 128 * qb;
                u.Q = QKV + row0 * NIN + 1536 + h * 128; u.ldq = NIN; u.nq = 128; u.qpos0 = 128 * qb;
                u.K0 = nullptr; u.V0 = nullptr; u.ld0 = 0; u.nt0 = 0;
                u.K1 = QKV + (size_t)n * SEQ * NIN + 2048 + h * 128; u.V1 = QKV + (size_t)n * SEQ * NIN + 2560 + h * 128; u.ld1 = NIN; u.n1 = 0x7fffffff;
                u.kpos0 = 0; u.tb = 0; u.te = 2 * qb + 2; u.nkeys = 0x7fffffff; u.head = h; u.O = YB + row0 * 512 + h * 128; u.ldo = 512;
                attn_unit<1, false>(lds, u, lam, rel_bias, subln);
            } else if (idx < N_SD + N_PD + N_PB) {
                const int j = idx - N_SD - N_PD, qb = 127 - (j >> 3), n = (j >> 2) & 1, hp = j & 3; const size_t row0 = (size_t)n * SEQ + 128 * qb;
                u.Q = QKV + row0 * NIN + hp * 128; u.ldq = NIN; u.nq = 128; u.qpos0 = 128 * qb;
                u.K0 = nullptr; u.V0 = nullptr; u.ld0 = 0; u.nt0 = 0;
                u.K1 = QKV + (size_t)n * SEQ * NIN + 512 + hp * 128; u.V1 = QKV + (size_t)n * SEQ * NIN + 1024 + hp * 128; u.ld1 = NIN; u.n1 = 0x7fffffff;
                u.kpos0 = 0; u.tb = (2 * qb - 8 > 0) ? 2 * qb - 8 : 0; u.te = 2 * qb + 2; u.nkeys = 0x7fffffff; u.head = 2 * hp; u.O = YA + row0 * 512 + hp * 128; u.ldo = 512;
                attn_unit<0, false>(lds, u, lam, rel_bias, subln);
            } else {
                const int j = idx - N_SD - N_PD - N_PB, n = j >> 2, hp = j & 3; const size_t row0 = MP + (size_t)n * DS;
                u.Q = QKV + row0 * NIN + hp * 128; u.ldq = NIN; u.nq = DS; u.qpos0 = PAST;
                u.K0 = cak + (size_t)n * LA * 512 + hp * 128; u.V0 = cav + (size_t)n * LA * 512 + hp * 128; u.ld0 = 512; u.nt0 = LA / 64;
                u.K1 = out + O_AKS + ((size_t)n * LA + (LA - DS)) * 512 + hp * 128; u.V1 = out + O_AVS + ((size_t)n * LA + (LA - DS)) * 512 + hp * 128; u.ld1 = 512; u.n1 = DS;
                u.kpos0 = PAST - LA; u.tb = 1; u.te = LA / 64 + 1; u.nkeys = LA + DS; u.head = 2 * hp; u.O = YA + row0 * 512 + hp * 128; u.ldo = 512;
                attn_unit<0, true>(lds, u, lam, rel_bias, subln);
            }
        }
    }
    SEAM(5);
    if (IN(6)) { EpiBrA e{GATES, DF}; GEMM_PHASE(EpiBrA, e, YA, W_BRA, MT, DM, 512, bx); }
    SEAM(6);
    if (IN(7)) { EpiBrB e{GATES, DF, XN}; GEMM_PHASE(EpiBrB, e, YB, W_BRB, MT, DM, 512, bx); }
    SEAM(7);
    if (IN(8)) { EpiF32 e{DF, DM}; GEMM_PHASE(EpiF32, e, XN, W_OUT, MT, DM, DM, bx); }
    SEAM(8);
    if (IN(9)) { for (int m = gw; m < MT; m += NGW) res_row<false>(H + (size_t)m * DM, DF + (size_t)m * DM, ng + 3 * DM, 1.0f, H + (size_t)m * DM, ng + 4 * DM, XN + (size_t)m * DM, lane); }
    SEAM(9);
    if (IN(10)) { EpiBf16 e{QM, DM}; GEMM_PHASE(EpiBf16, e, XN, W_MQ, MT, DM, DM, bx); }
    SEAM(10);
    if (IN(11)) {
        constexpr int N_S = DB * 4, N_P = NB * 4 * 128, N_ALL = N_S + N_P;
        volatile LAS unsigned* qw = (volatile LAS unsigned*)(lds + LDS_QW);
        for (;;) {
            __syncthreads();
            if (tid == 0) qw[0] = atomicAdd(&ctl[1], 1u);
            __syncthreads();
            int idx = (int)qw[0];
            if (idx >= N_ALL) break;
            AUnit u; u.qpos0 = 0; u.kpos0 = 0; u.tb = 0; u.te = MEMT / 64; u.nkeys = 0x7fffffff; u.ldq = DM; u.ldo = DM;
            if (idx < N_S) {
                const int n = idx >> 2, h = idx & 3; const size_t row0 = MP + (size_t)n * DS;
                u.Q = QM + row0 * DM + h * 256; u.nq = DS; u.head = h;
                u.K0 = nullptr; u.V0 = nullptr; u.ld0 = 0; u.nt0 = 0;
                u.K1 = MKS + (size_t)n * MEMT * 2048 + h * 256; u.V1 = MKS + (size_t)n * MEMT * 2048 + DM + h * 256; u.ld1 = 2048; u.n1 = 0x7fffffff; u.O = OM + row0 * DM + h * 256;
                attn_unit<2, false>(lds, u, 0.f, rel_bias, subln);
            } else {
                const int j = idx - N_S, qb = j >> 3, n = (j >> 2) & 1, h = j & 3; const size_t row0 = (size_t)n * SEQ + 128 * qb;
                u.Q = QM + row0 * DM + h * 256; u.nq = 128; u.head = h;
                u.K0 = nullptr; u.V0 = nullptr; u.ld0 = 0; u.nt0 = 0;
                u.K1 = MKB + (size_t)n * MEMT * 2048 + h * 256; u.V1 = MKB + (size_t)n * MEMT * 2048 + DM + h * 256; u.ld1 = 2048; u.n1 = 0x7fffffff; u.O = OM + row0 * DM + h * 256;
                attn_unit<2, false>(lds, u, 0.f, rel_bias, subln);
            }
        }
    }
    SEAM(11);
    if (IN(12)) { EpiF32 e{DF, DM}; GEMM_PHASE(EpiF32, e, OM, W_MO, MT, DM, DM, bx); }
    SEAM(12);
    if (IN(13)) { for (int m = gw; m < MT; m += NGW) res_row<false>(H + (size_t)m * DM, DF + (size_t)m * DM, ng + 5 * DM, 1.0f, H + (size_t)m * DM, ng + 7 * DM, XN + (size_t)m * DM, lane); }
    SEAM(13);
    if (IN(14)) { EpiSwiglu e{ACT}; GEMM_PHASE(EpiSwiglu, e, XN, W_UP2, MT, NUP, DM, bx); }
    SEAM(14);
    if (IN(15)) { EpiF32 e{DF, DM}; GEMM_PHASE(EpiF32, e, ACT, W_DN2, MT, DM, DFF, bx); }
    SEAM(15);
    if (IN(16)) { for (int m = gw; m < MT; m += NGW) res_row<true>(H + (size_t)m * DM, DF + (size_t)m * DM, ng + 8 * DM, 0.5f, out + O_YP + (size_t)m * DM, nullptr, nullptr, lane); }
#undef IN
#undef SEAM
#undef GEMM_PHASE
}
constexpr int N_PHASES = 17;

extern "C" void kernel_launch(void* const* d_in, const int* in_sizes, int n_in, void* d_out, int out_size, void* d_ws, size_t ws_size, hipStream_t stream) {
    static int grid = 0;
    if (grid == 0) {
        if (n_in != 26 || (size_t)out_size != O_END || ws_size < WS_END) { fprintf(stderr, "kernel_launch: unexpected shapes: n_in %d out %d (want %zu) ws %zu (want %zu)\n", n_in, out_size, (size_t)O_END, ws_size, (size_t)WS_END); grid = -1; return; }
        int dev = 0, cus = 0, per_cu = 0;
        hipGetDevice(&dev); hipDeviceGetAttribute(&cus, hipDeviceAttributeMultiprocessorCount, dev);
        if (hipFuncSetAttribute((const void*)fwd_kernel, hipFuncAttributeMaxDynamicSharedMemorySize, LDS_BYTES) != hipSuccess) { fprintf(stderr, "kernel_launch: hipFuncSetAttribute failed\n"); grid = -1; return; }
        if (hipOccupancyMaxActiveBlocksPerMultiprocessor(&per_cu, (const void*)fwd_kernel, 512, LDS_BYTES) != hipSuccess || per_cu < 1) { fprintf(stderr, "kernel_launch: occupancy query says %d\n", per_cu); per_cu = 1; }
        (void)hipGetLastError();
        grid = cus * 1;
        if (grid <= 0) grid = 256;
    }
    if (grid < 0) return;
    (void)hipMemsetAsync((char*)d_ws + WS_CTL, 0, 4096, stream);
    Args a{};
    for (int i = 0; i < 26; ++i) a.in[i] = (const float*)d_in[i];
    a.out = (float*)d_out; a.ws = (unsigned char*)d_ws;
#if MK_MULTI
    for (int p = 0; p < N_PHASES; ++p) { a.ph_lo = p; a.ph_hi = p + 1; hipLaunchKernelGGL(fwd_kernel, dim3(grid), dim3(512), LDS_BYTES, stream, a); }
#else
    a.ph_lo = 0; a.ph_hi = N_PHASES;
    void* kargs[] = {&a};
    hipError_t e = hipLaunchCooperativeKernel((const void*)fwd_kernel, dim3(grid), dim3(512), kargs, LDS_BYTES, stream);
    if (e != hipSuccess) fprintf(stderr, "kernel_launch: cooperative launch failed: %s (grid %d)\n", hipGetErrorString(e), grid);
#endif
}
```

```cpp
#include <hip/hip_runtime.h>
#include <hip/hip_cooperative_groups.h>
#include <cstdio>
#include <cstdint>
namespace cg = cooperative_groups;
#ifndef MK_MULTI
#define MK_MULTI 0
#endif
namespace pg8 {
#define PG8_LAS __attribute__((address_space(3)))
typedef unsigned short bf16_t;
typedef short bf16x8 __attribute__((ext_vector_type(8)));
typedef float f32x4 __attribute__((ext_vector_type(4)));
typedef unsigned u32x4 __attribute__((ext_vector_type(4)));
constexpr int BM = 256, BK = 64, HALF = 128, HTB = HALF * BK * 2  , STAGE_BYTES = 8 * HTB, NXCD = 8, WGM = 8;

__host__ __device__ __forceinline__ int lds_byte(int r, int c) { const int st = (r >> 4) * 2 + (c >> 5), rr = r & 15, cc = c & 31, ob = rr * 64 + cc * 2; return st * 1024 + (ob ^ (((ob >> 9) & 1) << 5)); }
__host__ __device__ __forceinline__ void stage_rc(int b, int& R, int& C) { const int st = b / 1024, sb = b % 1024, swz = sb ^ (((sb >> 9) & 1) << 5); R = (st >> 1) * 16 + swz / 64; C = (st & 1) * 32 + (swz % 64) / 2; }
__host__ __device__ __forceinline__ int perm32(int rho) { const int n = rho >> 4, i = rho & 15; return 8 * (i >> 2) + 4 * n + (i & 3); }

struct Unit { int pm, pn; };
struct Gemm { const bf16_t* A; const bf16_t* Bt; int M, N, K; };

struct StaticOrder {
    int nM, nN, nwg, G, c;
    __host__ __device__ void init(int M, int N, int G_, int c_) { nM = M / BM; nN = N / BM; nwg = nM * nN; G = G_; c = c_; }
    __host__ __device__ bool next(int i, Unit& u) const {
        const long L = (long)i * G + c; if (L >= nwg) return false;
        int wgid = (int)L; { const int q = nwg / NXCD, r = nwg % NXCD, xcd = wgid % NXCD, off = wgid / NXCD; wgid = (xcd < r ? xcd * (q + 1) : r * (q + 1) + (xcd - r) * q) + off; }
        const int nig = WGM * nN, gid = wgid / nig, fm = gid * WGM, gsz = (nM - fm) < WGM ? (nM - fm) : WGM;
        u.pm = fm + ((wgid % nig) % gsz); u.pn = (wgid % nig) / gsz; return true;
    }
    __device__ __forceinline__ void a_ready(const Unit&) const {}
    __device__ __forceinline__ void done(const Unit&) const {}
};

__device__ __forceinline__ unsigned cvt_pk_bf16(float lo, float hi) { unsigned r; asm volatile("v_cvt_pk_bf16_f32 %0, %1, %2" : "=v"(r) : "v"(lo), "v"(hi)); return r; }
typedef float f32x2 __attribute__((ext_vector_type(2)));
template <class Epi, class Sched, bool ALIGN_EPI = false, bool SP2 = false>
__device__ __forceinline__ void gemm_phase(PG8_LAS unsigned char* lds, const Gemm g, const Sched& S, const Epi& E) {
    const int tid = threadIdx.x, wid = __builtin_amdgcn_readfirstlane(tid >> 6), lane = tid & 63, wr = wid >> 2, wc = wid & 3, fr = lane & 15, fq = lane >> 4;
    const int K = g.K, nt = K / BK;
    unsigned voffA[2], voffB[2];
#pragma unroll
    for (int i = 0; i < 2; ++i) { int R, C; stage_rc(tid * 16 + i * 8192, R, C); const int Rb = Epi::PERM ? ((R & ~31) + perm32(R & 31)) : R;
        voffA[i] = (unsigned)(R * K + C) * 2u; voffB[i] = (unsigned)(Rb * K + C) * 2u; }
    const size_t kstep = (size_t)(BK * 2);
    const size_t hstep = (size_t)HALF * K * 2;
    const size_t tstep = 2 * hstep;
    const unsigned ldsw = (unsigned)wid * 1024u;
    const int aoff = lds_byte(wr * 64 + fr, fq * 8), boff = lds_byte(wc * 32 + fr, fq * 8);
#define PG8_SA(b, h) (((b) * 2 + (h)) * HTB)
#define PG8_SB(b, h) ((4 + (b) * 2 + (h)) * HTB)
#define PG8_STAGE(bufoff, gbase, voff) do { _Pragma("unroll") for (int _i = 0; _i < 2; ++_i) \
        __builtin_amdgcn_global_load_lds((const unsigned*)((const char*)(gbase) + (voff)[_i]), (PG8_LAS unsigned*)(lds + (bufoff) + ldsw + _i * 8192), 16, 0, 0); } while (0)
#define PG8_LDA(dst, b, h) do { _Pragma("unroll") for (int m = 0; m < 4; ++m) _Pragma("unroll") for (int k = 0; k < 2; ++k) dst[m][k] = *(const PG8_LAS bf16x8*)(lds + PG8_SA(b, h) + aoff + m * 2048 + k * 1024); } while (0)
#define PG8_LDB(dst, b, h) do { _Pragma("unroll") for (int n = 0; n < 2; ++n) _Pragma("unroll") for (int k = 0; k < 2; ++k) dst[n][k] = *(const PG8_LAS bf16x8*)(lds + PG8_SB(b, h) + boff + n * 2048 + k * 1024); } while (0)
#define PG8_MMA(ai, bj, At, Bt) do { __builtin_amdgcn_s_setprio(1); _Pragma("unroll") for (int m = 0; m < 4; ++m) _Pragma("unroll") for (int n = 0; n < 2; ++n) _Pragma("unroll") for (int k = 0; k < 2; ++k) \
        acc[ai][bj][m][n] = __builtin_amdgcn_mfma_f32_16x16x32_bf16(Bt[n][k], At[m][k], acc[ai][bj][m][n], 0, 0, 0); __builtin_amdgcn_s_setprio(0); } while (0)
#define PG8_WAIT_V(n) asm volatile("s_waitcnt vmcnt(" #n ")" ::: "memory")
#define PG8_WAIT_L(n) asm volatile("s_waitcnt lgkmcnt(" #n ")" ::: "memory")
#define PG8_BAR __builtin_amdgcn_s_barrier()
#define PG8_SCHED __builtin_amdgcn_sched_barrier(0)
    Unit cur, nxt; int ui = 0;
    if (!S.next(0, cur)) return;
    f32x4 acc[2][2][4][2];
#pragma unroll
    for (int a = 0; a < 2; ++a)
#pragma unroll
        for (int b = 0; b < 2; ++b)
#pragma unroll
            for (int m = 0; m < 4; ++m)
#pragma unroll
                for (int n = 0; n < 2; ++n) acc[a][b][m][n] = (f32x4){0.f, 0.f, 0.f, 0.f};
    bf16x8 At[4][2], B0[2][2], B1[2][2];
    const char* cA = (const char*)g.A + (size_t)cur.pm * tstep; const char* cB = (const char*)g.Bt + (size_t)cur.pn * tstep;
    S.a_ready(cur);
    if constexpr (SP2) {
        PG8_STAGE(PG8_SB(0, 0), cB, voffB); PG8_STAGE(PG8_SB(0, 1), cB + hstep, voffB); PG8_STAGE(PG8_SA(0, 0), cA, voffA); PG8_STAGE(PG8_SA(0, 1), cA + hstep, voffA);
        if (wr == 1) PG8_BAR;
        PG8_WAIT_V(2); PG8_BAR;
        PG8_STAGE(PG8_SB(1, 0), cB + kstep, voffB); PG8_STAGE(PG8_SA(1, 0), cA + kstep, voffA); PG8_STAGE(PG8_SB(1, 1), cB + hstep + kstep, voffB);
        PG8_WAIT_V(6); PG8_BAR;
    } else {
        PG8_STAGE(PG8_SB(0, 0), cB, voffB); PG8_STAGE(PG8_SA(0, 0), cA, voffA); PG8_STAGE(PG8_SB(0, 1), cB + hstep, voffB); PG8_STAGE(PG8_SA(0, 1), cA + hstep, voffA);
        if (wr == 1) PG8_BAR;
        PG8_WAIT_V(4); PG8_BAR;
        PG8_STAGE(PG8_SB(1, 0), cB + kstep, voffB); PG8_STAGE(PG8_SA(1, 0), cA + kstep, voffA); PG8_STAGE(PG8_SB(1, 1), cB + hstep + kstep, voffB);
        PG8_WAIT_V(6); PG8_BAR;
    }
    for (;;) {
        const bool has_next = S.next(ui + 1, nxt);
        const char* nA = has_next ? (const char*)g.A + (size_t)nxt.pm * tstep : cA; const char* nB = has_next ? (const char*)g.Bt + (size_t)nxt.pn * tstep : cB;
        for (int t = 0; t < nt; t += 2) {
            const bool last = (t == nt - 2);
            const char* a1 = cA + (size_t)(t + 1) * kstep;
            const char* a2 = last ? nA : cA + (size_t)(t + 2) * kstep; const char* b2 = last ? nB : cB + (size_t)(t + 2) * kstep;
            const char* a3 = a2 + kstep; const char* b3 = b2 + kstep;
            if (last && has_next) S.a_ready(nxt);
            if constexpr (SP2) {
            PG8_LDB(B0, 0, 0); PG8_LDB(B1, 0, 1); PG8_SCHED; PG8_LDA(At, 0, 0); PG8_STAGE(PG8_SA(1, 1), a1 + hstep, voffA);
            PG8_WAIT_V(8); PG8_WAIT_L(0); PG8_BAR; PG8_MMA(0, 0, At, B0); PG8_MMA(0, 1, At, B1); PG8_BAR; PG8_SCHED;
            PG8_LDA(At, 0, 1); PG8_STAGE(PG8_SB(0, 0), b2, voffB); PG8_STAGE(PG8_SB(0, 1), b2 + hstep, voffB); PG8_STAGE(PG8_SA(0, 0), a2, voffA);
            PG8_WAIT_V(8); PG8_WAIT_L(0); PG8_BAR; PG8_MMA(1, 0, At, B0); PG8_MMA(1, 1, At, B1); PG8_BAR; PG8_SCHED;
            PG8_LDB(B0, 1, 0); PG8_LDB(B1, 1, 1); PG8_SCHED; PG8_LDA(At, 1, 0); PG8_STAGE(PG8_SA(0, 1), a2 + hstep, voffA);
            PG8_WAIT_V(8); PG8_WAIT_L(0); PG8_BAR; PG8_MMA(0, 0, At, B0); PG8_MMA(0, 1, At, B1); PG8_BAR; PG8_SCHED;
            PG8_LDA(At, 1, 1); PG8_STAGE(PG8_SB(1, 0), b3, voffB); PG8_STAGE(PG8_SB(1, 1), b3 + hstep, voffB); PG8_STAGE(PG8_SA(1, 0), a3, voffA);
            PG8_WAIT_V(8); PG8_WAIT_L(0); PG8_BAR; PG8_MMA(1, 0, At, B0); PG8_MMA(1, 1, At, B1); PG8_BAR; PG8_SCHED;
            } else {
            PG8_LDB(B0, 0, 0); PG8_SCHED; PG8_LDA(At, 0, 0); PG8_STAGE(PG8_SA(1, 1), a1 + hstep, voffA);
            PG8_WAIT_L(8); PG8_BAR; PG8_WAIT_L(0); PG8_MMA(0, 0, At, B0); PG8_BAR; PG8_SCHED;
            PG8_LDB(B1, 0, 1); PG8_STAGE(PG8_SB(0, 0), b2, voffB);
            PG8_BAR; PG8_WAIT_L(0); PG8_MMA(0, 1, At, B1); PG8_BAR;
            PG8_LDA(At, 0, 1); PG8_STAGE(PG8_SA(0, 0), a2, voffA);
            PG8_BAR; PG8_WAIT_L(0); PG8_MMA(1, 0, At, B0); PG8_BAR; PG8_SCHED;
            PG8_STAGE(PG8_SB(0, 1), b2 + hstep, voffB);
            PG8_WAIT_V(6); PG8_BAR; PG8_MMA(1, 1, At, B1); PG8_BAR;
            PG8_LDB(B0, 1, 0); PG8_SCHED; PG8_LDA(At, 1, 0); PG8_STAGE(PG8_SA(0, 1), a2 + hstep, voffA);
            PG8_WAIT_L(8); PG8_BAR; PG8_WAIT_L(0); PG8_MMA(0, 0, At, B0); PG8_BAR; PG8_SCHED;
            PG8_LDB(B1, 1, 1); PG8_STAGE(PG8_SB(1, 0), b3, voffB);
            PG8_BAR; PG8_WAIT_L(0); PG8_MMA(0, 1, At, B1); PG8_BAR;
            PG8_LDA(At, 1, 1); PG8_STAGE(PG8_SA(1, 0), a3, voffA);
            PG8_BAR; PG8_WAIT_L(0); PG8_MMA(1, 0, At, B0); PG8_BAR; PG8_SCHED;
            PG8_STAGE(PG8_SB(1, 1), b3 + hstep, voffB);
            PG8_WAIT_V(6); PG8_BAR; PG8_MMA(1, 1, At, B1); PG8_BAR;
            }
        }
        if constexpr (ALIGN_EPI) { if (wr == 0) PG8_BAR; }
        if constexpr (!Epi::AFTER_DRAIN) { E(acc, cur, wr, wc, fr, fq); S.done(cur); }
        if (!has_next) break;
#pragma unroll
        for (int a = 0; a < 2; ++a)
#pragma unroll
            for (int b = 0; b < 2; ++b)
#pragma unroll
                for (int m = 0; m < 4; ++m)
#pragma unroll
                    for (int n = 0; n < 2; ++n) acc[a][b][m][n] = (f32x4){0.f, 0.f, 0.f, 0.f};
        cur = nxt; cA = nA; cB = nB; ++ui;
        if constexpr (ALIGN_EPI) { if (wr == 1) PG8_BAR; }
    }
    PG8_WAIT_V(0);
    if constexpr (!ALIGN_EPI) { if (wr == 0) PG8_BAR; }
    PG8_BAR;
    if constexpr (Epi::AFTER_DRAIN) { E.fused(acc, cur, wr, wc, fr, fq, lds, wid, lane); S.done(cur); }
#undef PG8_SA
#undef PG8_SB
#undef PG8_STAGE
#undef PG8_LDA
#undef PG8_LDB
#undef PG8_MMA
#undef PG8_WAIT_V
#undef PG8_WAIT_L
#undef PG8_BAR
#undef PG8_SCHED
}
}

#define LAS __attribute__((address_space(3)))
typedef unsigned short bf16_t;
typedef short bf16x8 __attribute__((ext_vector_type(8)));
typedef short s16x4 __attribute__((ext_vector_type(4)));
typedef float f32x4 __attribute__((ext_vector_type(4)));
typedef float f32x16 __attribute__((ext_vector_type(16)));
typedef unsigned u32x4 __attribute__((ext_vector_type(4)));
typedef unsigned u32x2 __attribute__((ext_vector_type(2)));
typedef float f32x2_t __attribute__((ext_vector_type(2))); typedef __bf16 bf16x2_t __attribute__((ext_vector_type(2)));
__device__ __forceinline__ unsigned cvt_pk_bf16(float lo, float hi) { f32x2_t v = {lo, hi}; bf16x2_t b = __builtin_convertvector(v, bf16x2_t); return __builtin_bit_cast(unsigned, b); }

constexpr int DM = 1024, SEQ = 16384, NB = 2, DB = 32, DS = 16, PAST = 4096, LA = 576;
constexpr int MP = NB * SEQ, MS = DB * DS, MT = MP + MS;
constexpr int DFF = 2816, NUP = 2 * DFF, NIN = 3072, NGATE = 2048, NING = NIN + NGATE, MEMT = 256;
constexpr float EPS = 1e-6f, LOG2E = 1.4426950408889634f;
static_assert(MT % 256 == 0, "rows");

constexpr size_t O_YP = 0, O_YS = O_YP + (size_t)MP * DM, O_AKP = O_YS + (size_t)MS * DM, O_AVP = O_AKP + (size_t)NB * LA * 512,
    O_BKP = O_AVP + (size_t)NB * LA * 512, O_BVP = O_BKP + (size_t)MP * 512, O_MKP = O_BVP + (size_t)MP * 512, O_MVP = O_MKP + (size_t)NB * MEMT * DM,
    O_AKS = O_MVP + (size_t)NB * MEMT * DM, O_AVS = O_AKS + (size_t)DB * LA * 512, O_BKS = O_AVS + (size_t)DB * LA * 512, O_BVS = O_BKS + (size_t)MS * 512,
    O_END = O_BVS + (size_t)MS * 512;

constexpr size_t MiB = 1u << 20;
constexpr size_t WS_CTL = 0;
constexpr size_t WS_UP1 = 1 * MiB, WS_DN1 = WS_UP1 + 11 * MiB, WS_ING = WS_DN1 + 6 * MiB, WS_BRA = WS_ING + 10 * MiB, WS_BRB = WS_BRA + 1 * MiB,
    WS_OUT = WS_BRB + 1 * MiB, WS_MQ = WS_OUT + 2 * MiB, WS_MKV = WS_MQ + 2 * MiB, WS_MO = WS_MKV + 4 * MiB, WS_UP2 = WS_MO + 2 * MiB, WS_DN2 = WS_UP2 + 11 * MiB,
    WS_MKB = WS_DN2 + 6 * MiB, WS_MEMN = WS_MKB + 2 * MiB, WS_XN = WS_MEMN + 1 * MiB, WS_ACT = WS_XN + 65 * MiB, WS_DF = WS_ACT + 179 * MiB,
    WS_H = WS_DF + 130 * MiB, WS_QKV = WS_H + 130 * MiB, WS_GATES = WS_QKV + 195 * MiB, WS_YA = WS_GATES + 130 * MiB, WS_YB = WS_YA + 33 * MiB, WS_MKS = WS_YB + 33 * MiB, WS_END = WS_MKS + 32 * MiB;
static_assert(WS_END <= 1024 * MiB, "workspace map");

constexpr int LDS_BYTES = 147456;
constexpr int LDS_QW = 140 * 1024;

struct Args { const float* in[26]; float* out; unsigned char* ws; int ph_lo, ph_hi; };

__device__ __forceinline__ float bf_lo(unsigned u) { return __uint_as_float(u << 16); }
__device__ __forceinline__ float bf_hi(unsigned u) { return __uint_as_float(u & 0xffff0000u); }
__device__ __forceinline__ float wave_sum(float v) {
#pragma unroll
    for (int o = 1; o < 64; o <<= 1) v += __shfl_xor(v, o);
    return v;
}
__device__ __forceinline__ u32x4 pack8(const float* v) {
    u32x4 w; w.x = cvt_pk_bf16(v[0], v[1]); w.y = cvt_pk_bf16(v[2], v[3]); w.z = cvt_pk_bf16(v[4], v[5]); w.w = cvt_pk_bf16(v[6], v[7]); return w;
}

#define EPI_ROWS_BEGIN _Pragma("unroll") for (int ai = 0; ai < 2; ++ai) _Pragma("unroll") for (int m = 0; m < 4; ++m) { const int row = u.pm * 256 + ai * 128 + wr * 64 + m * 16 + fr;
#define EPI_ROWS_END }
#define EPI_V8(bj) float v[8]; { const f32x4 a0 = acc[ai][bj][m][0], a1 = acc[ai][bj][m][1]; v[0] = a0[0]; v[1] = a0[1]; v[2] = a0[2]; v[3] = a0[3]; v[4] = a1[0]; v[5] = a1[1]; v[6] = a1[2]; v[7] = a1[3]; }
typedef const f32x4 (&AccRef)[2][2][4][2];

struct EpiSwiglu {
    static constexpr bool PERM = true, AFTER_DRAIN = false; bf16_t* O;
    __device__ __forceinline__ void operator()(AccRef acc, const pg8::Unit& u, int wr, int wc, int fr, int fq) const {
        const int col = u.pn * 128 + wc * 32 + 8 * fq;
        EPI_ROWS_BEGIN
            float o[8];
#pragma unroll
            for (int n = 0; n < 2; ++n)
#pragma unroll
                for (int i = 0; i < 4; ++i) { const float g = acc[ai][0][m][n][i], up = acc[ai][1][m][n][i];
                    const float sg = g * __builtin_amdgcn_rcpf(1.0f + __builtin_amdgcn_exp2f(-g * LOG2E)); o[n * 4 + i] = sg * up; }
            *(u32x4*)(O + (size_t)row * DFF + col) = pack8(o);
        EPI_ROWS_END
    }
};
struct EpiF32 {
    static constexpr bool PERM = true, AFTER_DRAIN = false; float* O; int ldc;
    __device__ __forceinline__ void operator()(AccRef acc, const pg8::Unit& u, int wr, int wc, int fr, int fq) const {
        EPI_ROWS_BEGIN
#pragma unroll
            for (int bj = 0; bj < 2; ++bj) { float* p = O + (size_t)row * ldc + u.pn * 256 + bj * 128 + wc * 32 + 8 * fq;
                *(f32x4*)p = acc[ai][bj][m][0]; *(f32x4*)(p + 4) = acc[ai][bj][m][1]; }
        EPI_ROWS_END
    }
};
struct EpiBf16 {
    static constexpr bool PERM = true, AFTER_DRAIN = false; bf16_t* O; int ldc;
    __device__ __forceinline__ void operator()(AccRef acc, const pg8::Unit& u, int wr, int wc, int fr, int fq) const {
        EPI_ROWS_BEGIN
#pragma unroll
            for (int bj = 0; bj < 2; ++bj) { EPI_V8(bj); *(u32x4*)(O + (size_t)row * ldc + u.pn * 256 + bj * 128 + wc * 32 + 8 * fq) = pack8(v); }
        EPI_ROWS_END
    }
};
struct EpiBrA {
    static constexpr bool PERM = true, AFTER_DRAIN = false; const bf16_t* G; float* T;
    __device__ __forceinline__ void operator()(AccRef acc, const pg8::Unit& u, int wr, int wc, int fr, int fq) const {
        EPI_ROWS_BEGIN
#pragma unroll
            for (int bj = 0; bj < 2; ++bj) { const int col = u.pn * 256 + bj * 128 + wc * 32 + 8 * fq; EPI_V8(bj);
                const u32x4 g = *(const u32x4*)(G + (size_t)row * NGATE + col);
                f32x4 o0, o1; o0[0] = v[0] * bf_lo(g.x); o0[1] = v[1] * bf_hi(g.x); o0[2] = v[2] * bf_lo(g.y); o0[3] = v[3] * bf_hi(g.y);
                o1[0] = v[4] * bf_lo(g.z); o1[1] = v[5] * bf_hi(g.z); o1[2] = v[6] * bf_lo(g.w); o1[3] = v[7] * bf_hi(g.w);
                float* p = T + (size_t)row * DM + col; *(f32x4*)p = o0; *(f32x4*)(p + 4) = o1; }
        EPI_ROWS_END
    }
};
struct EpiBrB {
    static constexpr bool PERM = true, AFTER_DRAIN = false; const bf16_t* G; const float* T; bf16_t* O;
    __device__ __forceinline__ void operator()(AccRef acc, const pg8::Unit& u, int wr, int wc, int fr, int fq) const {
        EPI_ROWS_BEGIN
#pragma unroll
            for (int bj = 0; bj < 2; ++bj) { const int col = u.pn * 256 + bj * 128 + wc * 32 + 8 * fq; EPI_V8(bj);
                const u32x4 g = *(const u32x4*)(G + (size_t)row * NGATE + DM + col);
                const float* p = T + (size_t)row * DM + col; const f32x4 t0 = *(const f32x4*)p, t1 = *(const f32x4*)(p + 4);
                float o[8]; o[0] = t0[0] + v[0] * bf_lo(g.x); o[1] = t0[1] + v[1] * bf_hi(g.x); o[2] = t0[2] + v[2] * bf_lo(g.y); o[3] = t0[3] + v[3] * bf_hi(g.y);
                o[4] = t1[0] + v[4] * bf_lo(g.z); o[5] = t1[1] + v[5] * bf_hi(g.z); o[6] = t1[2] + v[6] * bf_lo(g.w); o[7] = t1[3] + v[7] * bf_hi(g.w);
                *(u32x4*)(O + (size_t)row * DM + col) = pack8(o); }
        EPI_ROWS_END
    }
};
struct EpiMemKV {
    static constexpr bool PERM = true, AFTER_DRAIN = false; float* out; bf16_t* MKB;
    __device__ __forceinline__ void operator()(AccRef acc, const pg8::Unit& u, int wr, int wc, int fr, int fq) const {
        EPI_ROWS_BEGIN
#pragma unroll
            for (int bj = 0; bj < 2; ++bj) { const int col = u.pn * 256 + bj * 128 + wc * 32 + 8 * fq; EPI_V8(bj);
                float* p = out + (col < DM ? O_MKP + (size_t)row * DM + col : O_MVP + (size_t)row * DM + (col - DM));
                *(f32x4*)p = acc[ai][bj][m][0]; *(f32x4*)(p + 4) = acc[ai][bj][m][1];
                *(u32x4*)(MKB + (size_t)row * 2048 + col) = pack8(v); }
        EPI_ROWS_END
    }
};
struct EpiInGate {
    static constexpr bool PERM = true, AFTER_DRAIN = false; bf16_t* QKV; bf16_t* G; const float* bg; float* out; bf16_t* VTA; bf16_t* VTB;
    __device__ __forceinline__ void operator()(AccRef acc, const pg8::Unit& u, int wr, int wc, int fr, int fq) const {
        const int region = u.pn >> 1;
        EPI_ROWS_BEGIN
            const bool samp = row >= MP;
#pragma unroll
            for (int bj = 0; bj < 2; ++bj) { const int col = u.pn * 256 + bj * 128 + wc * 32 + 8 * fq; EPI_V8(bj);
                if (u.pn < 12) {
                    const int cc = col - region * 512; float* p = nullptr;
                    if (region != 2 && region != 5) *(u32x4*)(QKV + (size_t)row * NIN + col) = pack8(v);
                    else if (!samp) { const u32x4 w8 = pack8(v); bf16_t* vt = (region == 2 ? VTA : VTB) + ((size_t)((row >> 14) * 512 + cc) * SEQ + (row & (SEQ - 1)));
                        vt[0 * (size_t)SEQ] = (bf16_t)(w8.x & 0xffffu); vt[1 * (size_t)SEQ] = (bf16_t)(w8.x >> 16); vt[2 * (size_t)SEQ] = (bf16_t)(w8.y & 0xffffu); vt[3 * (size_t)SEQ] = (bf16_t)(w8.y >> 16);
                        vt[4 * (size_t)SEQ] = (bf16_t)(w8.z & 0xffffu); vt[5 * (size_t)SEQ] = (bf16_t)(w8.z >> 16); vt[6 * (size_t)SEQ] = (bf16_t)(w8.w & 0xffffu); vt[7 * (size_t)SEQ] = (bf16_t)(w8.w >> 16); }
                    if (region == 1 || region == 2) {
                        if (!samp) { const int n = row >> 14, t = row & (SEQ - 1); if (t >= SEQ - LA) p = out + (region == 1 ? O_AKP : O_AVP) + ((size_t)(n * LA + t - (SEQ - LA)) * 512 + cc); }
                        else { const int rs = row - MP, n = rs >> 4, t = rs & 15; p = out + (region == 1 ? O_AKS : O_AVS) + ((size_t)(n * LA + (LA - DS) + t) * 512 + cc); }
                    } else if (region == 4 || region == 5) {
                        p = samp ? out + (region == 4 ? O_BKS : O_BVS) + ((size_t)(row - MP) * 512 + cc) : out + (region == 4 ? O_BKP : O_BVP) + ((size_t)row * 512 + cc);
                    }
                    if (p) { *(f32x4*)p = acc[ai][bj][m][0]; *(f32x4*)(p + 4) = acc[ai][bj][m][1]; }
                } else {
                    const int gc = col - NIN; const f32x4 b0 = *(const f32x4*)(bg + gc), b1 = *(const f32x4*)(bg + gc + 4);
                    float o[8];
#pragma unroll
                    for (int i = 0; i < 8; ++i) { const float z = v[i] + (i < 4 ? b0[i & 3] : b1[i & 3]); o[i] = __builtin_amdgcn_rcpf(1.0f + __builtin_amdgcn_exp2f(-z * LOG2E)); }
                    *(u32x4*)(G + (size_t)row * NGATE + gc) = pack8(o);
                }
            }
        EPI_ROWS_END
    }
};

__device__ __forceinline__ unsigned f2bf(float f) { unsigned u = __builtin_bit_cast(unsigned, f); return (u + 0x7fffu + ((u >> 16) & 1u)) >> 16; }
__device__ __forceinline__ unsigned pk2(float lo, float hi) { return f2bf(lo) | (f2bf(hi) << 16); }
__device__ __forceinline__ int up_row(int n) { return n < DFF ? ((n >> 7) << 8) + (n & 127) : ((((n - DFF) >> 7) << 8) + 128 + ((n - DFF) & 127)); }
template <bool UP> __device__ __forceinline__ void transpose_item(const float* W, int K, int N, bf16_t* WT, int row_off, LAS float* scr, int item, int lane) {
    const int nblk = N / 32, kb = item / nblk, nb = item % nblk, k0 = 64 * kb, n0 = 32 * nb;
#pragma unroll 8
    for (int i = 0; i < 32; ++i) { const int kk = 2 * i + (lane >> 5); scr[kk * 33 + (lane & 31)] = W[(size_t)(k0 + kk) * N + n0 + (lane & 31)]; }
    asm volatile("s_waitcnt lgkmcnt(0)" ::: "memory");
    const int c = lane & 7;
    const int r0 = UP ? up_row(n0) : row_off + n0;
#pragma unroll
    for (int j = 0; j < 4; ++j) { const int n = (lane >> 3) + 8 * j; const LAS float* s = scr + (8 * c) * 33 + n;
        u32x4 o; o.x = pk2(s[0 * 33], s[1 * 33]); o.y = pk2(s[2 * 33], s[3 * 33]); o.z = pk2(s[4 * 33], s[5 * 33]); o.w = pk2(s[6 * 33], s[7 * 33]);
        *(u32x4*)(WT + (size_t)(r0 + n) * K + k0 + 8 * c) = o; }
    asm volatile("s_waitcnt lgkmcnt(0)" ::: "memory");
}
__device__ __forceinline__ void rms_row_to_bf16(const float* xrow, const float* g, bf16_t* orow, int lane) {
    const f32x4* xr = (const f32x4*)xrow + lane; const f32x4* gr = (const f32x4*)g + lane;
    f32x4 v[4]; float s = 0.f;
#pragma unroll
    for (int j = 0; j < 4; ++j) { v[j] = xr[64 * j]; s += (v[j].x * v[j].x + v[j].y * v[j].y) + (v[j].z * v[j].z + v[j].w * v[j].w); }
    const float rstd = 1.0f / sqrtf(wave_sum(s) * (1.f / DM) + EPS);
    u32x2* o8 = (u32x2*)orow + lane;
#pragma unroll
    for (int j = 0; j < 4; ++j) { const f32x4 gg = gr[64 * j]; u32x2 w; w.x = cvt_pk_bf16(v[j].x * rstd * gg.x, v[j].y * rstd * gg.y); w.y = cvt_pk_bf16(v[j].z * rstd * gg.z, v[j].w * rstd * gg.w); o8[64 * j] = w; }
}
template <bool FINAL> __device__ __forceinline__ void res_row(const float* base, const float* d, const float* gres, float coef, float* outp, const float* gnorm, bf16_t* xn, int lane) {
    const f32x4* br = (const f32x4*)base + lane; const f32x4* dr = (const f32x4*)d + lane; const f32x4* gr = (const f32x4*)gres + lane;
    f32x4 dv[4], hv[4]; float s = 0.f;
#pragma unroll
    for (int j = 0; j < 4; ++j) { dv[j] = dr[64 * j]; hv[j] = br[64 * j]; s += (dv[j].x * dv[j].x + dv[j].y * dv[j].y) + (dv[j].z * dv[j].z + dv[j].w * dv[j].w); }
    const float rs = coef / sqrtf(wave_sum(s) * (1.f / DM) + EPS);
    float s2 = 0.f;
#pragma unroll
    for (int j = 0; j < 4; ++j) { const f32x4 gg = gr[64 * j]; hv[j] = hv[j] + dv[j] * gg * rs; s2 += (hv[j].x * hv[j].x + hv[j].y * hv[j].y) + (hv[j].z * hv[j].z + hv[j].w * hv[j].w);
        ((f32x4*)outp + lane)[64 * j] = hv[j]; }
    if (!FINAL) {
        const float rstd = 1.0f / sqrtf(wave_sum(s2) * (1.f / DM) + EPS);
        const f32x4* gn = (const f32x4*)gnorm + lane; u32x2* o8 = (u32x2*)xn + lane;
#pragma unroll
        for (int j = 0; j < 4; ++j) { const f32x4 gg = gn[64 * j]; u32x2 w; w.x = cvt_pk_bf16(hv[j].x * rstd * gg.x, hv[j].y * rstd * gg.y); w.y = cvt_pk_bf16(hv[j].z * rstd * gg.z, hv[j].w * rstd * gg.w); o8[64 * j] = w; }
    }
}

struct AUnit {
    const bf16_t* Q; int ldq; int nq; int qpos0;
    const void* K0; const void* V0; int ld0; int nt0;
    const void* K1; const void* V1; int ld1; int n1; int ldv1;
    int kpos0, tb, te, nkeys, head;
    bf16_t* O; int ldo;
};
template <bool F32> struct Piece;
template <> struct Piece<true> { f32x4 a, b; };
template <> struct Piece<false> { u32x4 a; };
__device__ __forceinline__ void piece_load(Piece<true>& p, const void* base, size_t eoff) { const float* s = (const float*)base + eoff; p.a = *(const f32x4*)s; p.b = *(const f32x4*)(s + 4); }
__device__ __forceinline__ void piece_load(Piece<false>& p, const void* base, size_t eoff) { p.a = *(const u32x4*)((const bf16_t*)base + eoff); }
__device__ __forceinline__ u32x4 piece_bf16(const Piece<true>& p) { u32x4 w; w.x = cvt_pk_bf16(p.a[0], p.a[1]); w.y = cvt_pk_bf16(p.a[2], p.a[3]); w.z = cvt_pk_bf16(p.b[0], p.b[1]); w.w = cvt_pk_bf16(p.b[2], p.b[3]); return w; }
__device__ __forceinline__ u32x4 piece_bf16(const Piece<false>& p) { return p.a; }

template <int MODE, bool F32>
__device__ __forceinline__ void attn_unit(LAS unsigned char* lds, const AUnit& u, const float lam, const float* __restrict__ relb, const float* __restrict__ subg) {
    constexpr bool VT = (MODE != 2) && !F32;
    constexpr int DQK = (MODE == 2) ? 256 : 64, KW = (MODE == 2) ? 256 : 128, DV = (MODE == 0) ? 64 : 128, VW = (MODE == 2) ? 256 : 128;
    constexpr int KSTRB = KW * 2 + 16, VSTRB = 136, VOFFB = 64 * KSTRB, STAGE = VOFFB + VW * VSTRB;
    constexpr int NKP = KW / 64, NVP = VW / 64, NDB = DV / 32;
    constexpr float SCL = ((MODE == 2) ? 0.0625f : 0.125f) * LOG2E, THR = 8.0f;
    const int tid = threadIdx.x, lane = tid & 63, wid = __builtin_amdgcn_readfirstlane(tid >> 6), r32 = lane & 31, hi = lane >> 5;
    const int qg = wid >> 1, s = wid & 1;
    const int koff = (KW == 2 * DQK) ? s * DQK : 0, voff = (VW == 2 * DV) ? s * DV : 0;
    const bool active = (qg * 32 < u.nq);
    const int qrow = qg * 32 + r32, qrow_c = qrow < u.nq ? qrow : u.nq - 1;
    const bf16_t* qp = u.Q + (size_t)qrow_c * u.ldq + ((MODE == 2) ? 0 : s * 64) + hi * 8;
    bf16x8 qf[4];
    if (MODE != 2 && !F32) {
#pragma unroll
        for (int d0 = 0; d0 < 4; ++d0) qf[d0] = *(const bf16x8*)(qp + d0 * 16);
    }
    const int pq = u.qpos0 + qrow;
    const int cq = (u.qpos0 + qg * 32) >> 6;
    float slope2 = 0.f;
    bf16x8 kaugA = {0, 0, 0, 0, 0, 0, 0, 0}, kaugB = {0, 0, 0, 0, 0, 0, 0, 0}, qaug = {0, 0, 0, 0, 0, 0, 0, 0};
    if (MODE == 1) {
        slope2 = __builtin_amdgcn_exp2f(-2.0f * (float)(u.head + 1)) * LOG2E;
        if (!F32 && hi == 0) { kaugA[0] = (short)(__float_as_uint((float)r32) >> 16); kaugB[0] = (short)(__float_as_uint((float)(32 + r32)) >> 16);
            qaug[0] = (short)(__float_as_uint(__builtin_amdgcn_exp2f((float)(1 - 2 * u.head))) >> 16); }
    }
    const float* rb = relb + (size_t)(u.head + s) * 257;
    float m_run = -1e30f, l_run = 0.f;
    f32x16 o[NDB];
#pragma unroll
    for (int db = 0; db < NDB; ++db)
#pragma unroll
        for (int r = 0; r < 16; ++r) o[db][r] = 0.f;
    Piece<F32> kr[NKP], vr[NVP];
#define ATT_LOAD(t) do { const int t_ = (t); const bool s0_ = t_ < u.nt0; const void* kb_ = s0_ ? u.K0 : u.K1; const void* vb_ = s0_ ? u.V0 : u.V1; const int ld_ = s0_ ? u.ld0 : u.ld1; \
        const int rb_ = s0_ ? 64 * t_ : 64 * (t_ - u.nt0); const int lim_ = s0_ ? 0x7fffffff : u.n1 - 1; \
        _Pragma("unroll") for (int i_ = 0; i_ < NKP; ++i_) { const int p_ = tid + 512 * i_; int row_ = rb_ + p_ / (KW / 8); row_ = row_ < lim_ ? row_ : lim_; piece_load(kr[i_], kb_, (size_t)row_ * ld_ + (p_ % (KW / 8)) * 8); } \
        if (VT) { _Pragma("unroll") for (int i_ = 0; i_ < NVP; ++i_) { const int p_ = tid + 512 * i_; piece_load(vr[i_], u.V1, (size_t)(p_ >> 3) * u.ldv1 + 64 * t_ + (p_ & 7) * 8); } } \
        else { _Pragma("unroll") for (int i_ = 0; i_ < NVP; ++i_) { const int w_ = (tid >> 6) + 8 * i_; int row_ = rb_ + 16 * (w_ & 3) + (lane & 15); row_ = row_ < lim_ ? row_ : lim_; piece_load(vr[i_], vb_, (size_t)row_ * ld_ + (4 * (w_ >> 2) + (lane >> 4)) * 8); } } } while (0)
#define ATT_WRITE(buf) do { LAS unsigned char* b_ = (buf); \
        _Pragma("unroll") for (int i_ = 0; i_ < NKP; ++i_) { const int p_ = tid + 512 * i_; *(LAS u32x4*)(b_ + (p_ / (KW / 8)) * KSTRB + (p_ % (KW / 8)) * 16) = piece_bf16(kr[i_]); } \
        if (VT) { _Pragma("unroll") for (int i_ = 0; i_ < NVP; ++i_) { const int p_ = tid + 512 * i_; const u32x4 w4_ = piece_bf16(vr[i_]); LAS unsigned char* vp_ = b_ + VOFFB + (p_ >> 3) * VSTRB + (p_ & 7) * 16; \
                *(LAS u32x2*)vp_ = (u32x2){w4_.x, w4_.y}; *(LAS u32x2*)(vp_ + 8) = (u32x2){w4_.z, w4_.w}; } } \
        else { _Pragma("unroll") for (int i_ = 0; i_ < NVP; ++i_) { const int w_ = (tid >> 6) + 8 * i_; const int row_ = 16 * (w_ & 3) + (lane & 15), c8_ = 4 * (w_ >> 2) + (lane >> 4); const u32x4 b4_ = piece_bf16(vr[i_]); \
                LAS bf16_t* vp_ = (LAS bf16_t*)(b_ + VOFFB + (c8_ * 8) * VSTRB) + row_; \
                vp_[0 * (VSTRB / 2)] = (bf16_t)(b4_.x & 0xffffu); vp_[1 * (VSTRB / 2)] = (bf16_t)(b4_.x >> 16); vp_[2 * (VSTRB / 2)] = (bf16_t)(b4_.y & 0xffffu); vp_[3 * (VSTRB / 2)] = (bf16_t)(b4_.y >> 16); \
                vp_[4 * (VSTRB / 2)] = (bf16_t)(b4_.z & 0xffffu); vp_[5 * (VSTRB / 2)] = (bf16_t)(b4_.z >> 16); vp_[6 * (VSTRB / 2)] = (bf16_t)(b4_.w & 0xffffu); vp_[7 * (VSTRB / 2)] = (bf16_t)(b4_.w >> 16); } } } while (0)
    const int nt = u.te - u.tb;
    ATT_LOAD(u.te - 1);
    ATT_WRITE(lds);
    if (nt > 1) ATT_LOAD(u.te - 2);
    __syncthreads();
    for (int j = 0; j < nt; ++j) {
        const int t = u.te - 1 - j;
        LAS unsigned char* cur = lds + (j & 1) * STAGE;
        if (j + 1 < nt) ATT_WRITE(lds + ((j + 1) & 1) * STAGE);
        if (!F32 && j + 2 < nt) ATT_LOAD(t - 2);
        const int ck = (u.kpos0 + 64 * t) >> 6;
        bool vis = active;
        if (MODE == 0) vis = vis && (ck <= cq) && (ck >= cq - 8);
        if (MODE == 1) vis = vis && (ck <= cq);
        if (vis) {
            f32x16 sA, sB;
#pragma unroll
            for (int r = 0; r < 16; ++r) { sA[r] = 0.f; sB[r] = 0.f; }
            const bool aug = (MODE == 1) && !F32 && (ck < cq);
            if (MODE == 1 && !F32 && aug) {
                sA = __builtin_amdgcn_mfma_f32_32x32x16_bf16(kaugA, qaug, sA, 0, 0, 0);
                sB = __builtin_amdgcn_mfma_f32_32x32x16_bf16(kaugB, qaug, sB, 0, 0, 0);
            }
            if (MODE != 2) {
#pragma unroll
                for (int d0 = 0; d0 < 4; ++d0) {
                    const bf16x8 ka = *(const LAS bf16x8*)(cur + r32 * KSTRB + (koff + d0 * 16 + hi * 8) * 2);
                    const bf16x8 kb = *(const LAS bf16x8*)(cur + (32 + r32) * KSTRB + (koff + d0 * 16 + hi * 8) * 2);
                    const bf16x8 q = F32 ? *(const bf16x8*)(qp + d0 * 16) : qf[d0];
                    sA = __builtin_amdgcn_mfma_f32_32x32x16_bf16(ka, q, sA, 0, 0, 0);
                    sB = __builtin_amdgcn_mfma_f32_32x32x16_bf16(kb, q, sB, 0, 0, 0);
                }
            } else {
#pragma unroll 4
                for (int d0 = 0; d0 < 16; ++d0) {
                    const bf16x8 q = *(const bf16x8*)(qp + d0 * 16);
                    const bf16x8 ka = *(const LAS bf16x8*)(cur + r32 * KSTRB + (koff + d0 * 16 + hi * 8) * 2);
                    const bf16x8 kb = *(const LAS bf16x8*)(cur + (32 + r32) * KSTRB + (koff + d0 * 16 + hi * 8) * 2);
                    sA = __builtin_amdgcn_mfma_f32_32x32x16_bf16(ka, q, sA, 0, 0, 0);
                    sB = __builtin_amdgcn_mfma_f32_32x32x16_bf16(kb, q, sB, 0, 0, 0);
                }
            }
            float SC = SCL, off = 0.f;
            const int rel0 = pq - (u.kpos0 + 64 * t) - 4 * hi;
            if (MODE == 1) {
                if (aug) off = slope2 * (float)(pq - (u.kpos0 + 64 * t));
                else { const float bf = (float)rel0; SC = 1.0f;
#pragma unroll
                    for (int r = 0; r < 16; ++r) { const float c = (float)((r & 3) + 8 * (r >> 2));
                        sA[r] = sA[r] * SCL - slope2 * __builtin_fabsf(bf - c); sB[r] = sB[r] * SCL - slope2 * __builtin_fabsf(bf - c - 32.0f); }
                }
            } else if (MODE == 0) {
                const int wmin = (u.qpos0 + qg * 32) - (u.kpos0 + 64 * t + 63);
                if (wmin >= 128) off = -rb[256] * LOG2E;
                else { SC = 1.0f;
#pragma unroll
                    for (int r = 0; r < 16; ++r) { const int c = (r & 3) + 8 * (r >> 2);
                        int ra = rel0 - c, rbb = rel0 - c - 32; ra = ra < -128 ? -128 : (ra > 128 ? 128 : ra); rbb = rbb < -128 ? -128 : (rbb > 128 ? 128 : rbb);
                        sA[r] = sA[r] * SCL + rb[ra + 128] * LOG2E; sB[r] = sB[r] * SCL + rb[rbb + 128] * LOG2E; }
                }
            }
            if (64 * (t + 1) > u.nkeys) {
                const int k0 = 64 * t + 4 * hi;
#pragma unroll
                for (int r = 0; r < 16; ++r) { const int c = (r & 3) + 8 * (r >> 2); if (k0 + c >= u.nkeys) sA[r] = -INFINITY; if (k0 + c + 32 >= u.nkeys) sB[r] = -INFINITY; }
            }
            float mxa = __builtin_fmaxf(__builtin_fmaxf(sA[0], sA[1]), sB[0]), mxb = __builtin_fmaxf(__builtin_fmaxf(sA[2], sA[3]), sB[1]);
            mxa = __builtin_fmaxf(__builtin_fmaxf(mxa, sB[2]), sB[3]);
#pragma unroll
            for (int r = 4; r < 16; r += 4) { mxa = __builtin_fmaxf(__builtin_fmaxf(mxa, sA[r]), sA[r + 1]); mxb = __builtin_fmaxf(__builtin_fmaxf(mxb, sA[r + 2]), sA[r + 3]);
                mxa = __builtin_fmaxf(__builtin_fmaxf(mxa, sB[r]), sB[r + 1]); mxb = __builtin_fmaxf(__builtin_fmaxf(mxb, sB[r + 2]), sB[r + 3]); }
            float mx = __builtin_fmaxf(mxa, mxb);
            mx = __builtin_fmaxf(mx, __shfl_xor(mx, 32));
            const float smax = mx * SC - off;
            if (__any(smax > m_run + THR)) {
                const float m_new = __builtin_fmaxf(m_run, smax);
                const float alpha = __builtin_amdgcn_exp2f(m_run - m_new);
                m_run = m_new; l_run *= alpha;
#pragma unroll
                for (int db = 0; db < NDB; ++db)
#pragma unroll
                    for (int r = 0; r < 16; ++r) o[db][r] *= alpha;
            }
            const float cs = -(off + m_run);
            float rs0 = 0.f, rs1 = 0.f;
#pragma unroll
            for (int r = 0; r < 16; ++r) { sA[r] = __builtin_amdgcn_exp2f(__builtin_fmaf(sA[r], SC, cs)); sB[r] = __builtin_amdgcn_exp2f(__builtin_fmaf(sB[r], SC, cs)); rs0 += sA[r]; rs1 += sB[r]; }
            l_run += rs0 + rs1;
            u32x4 pa0, pa1, pb0, pb1;
            pa0.x = cvt_pk_bf16(sA[0], sA[1]); pa0.y = cvt_pk_bf16(sA[2], sA[3]); pa0.z = cvt_pk_bf16(sA[4], sA[5]); pa0.w = cvt_pk_bf16(sA[6], sA[7]);
            pa1.x = cvt_pk_bf16(sA[8], sA[9]); pa1.y = cvt_pk_bf16(sA[10], sA[11]); pa1.z = cvt_pk_bf16(sA[12], sA[13]); pa1.w = cvt_pk_bf16(sA[14], sA[15]);
            pb0.x = cvt_pk_bf16(sB[0], sB[1]); pb0.y = cvt_pk_bf16(sB[2], sB[3]); pb0.z = cvt_pk_bf16(sB[4], sB[5]); pb0.w = cvt_pk_bf16(sB[6], sB[7]);
            pb1.x = cvt_pk_bf16(sB[8], sB[9]); pb1.y = cvt_pk_bf16(sB[10], sB[11]); pb1.z = cvt_pk_bf16(sB[12], sB[13]); pb1.w = cvt_pk_bf16(sB[14], sB[15]);
#pragma unroll
            for (int db = 0; db < NDB; ++db) {
                const LAS unsigned char* vrow = cur + VOFFB + (voff + db * 32 + r32) * VSTRB + hi * 8;
#define ATT_VF(base) ({ const s16x4 lo_ = *(const LAS s16x4*)(vrow + (base) * 2), hi_ = *(const LAS s16x4*)(vrow + ((base) + 8) * 2); (bf16x8){lo_[0], lo_[1], lo_[2], lo_[3], hi_[0], hi_[1], hi_[2], hi_[3]}; })
                o[db] = __builtin_amdgcn_mfma_f32_32x32x16_bf16(ATT_VF(0), __builtin_bit_cast(bf16x8, pa0), o[db], 0, 0, 0);
                o[db] = __builtin_amdgcn_mfma_f32_32x32x16_bf16(ATT_VF(16), __builtin_bit_cast(bf16x8, pa1), o[db], 0, 0, 0);
                o[db] = __builtin_amdgcn_mfma_f32_32x32x16_bf16(ATT_VF(32), __builtin_bit_cast(bf16x8, pb0), o[db], 0, 0, 0);
                o[db] = __builtin_amdgcn_mfma_f32_32x32x16_bf16(ATT_VF(48), __builtin_bit_cast(bf16x8, pb1), o[db], 0, 0, 0);
#undef ATT_VF
                if (F32) __builtin_amdgcn_sched_barrier(0);
            }
        }
        if (F32 && j + 2 < nt) ATT_LOAD(t - 2);
        __syncthreads();
    }
#undef ATT_LOAD
#undef ATT_WRITE
    const float l_tot = l_run + __shfl_xor(l_run, 32);
    const float linv = 1.0f / l_tot;
    if (MODE != 1) {
        if (active && qrow < u.nq) {
            bf16_t* op = u.O + (size_t)qrow * u.ldo + ((MODE == 0) ? s * 64 : s * 128) + 4 * hi;
#pragma unroll
            for (int db = 0; db < NDB; ++db)
#pragma unroll
                for (int g = 0; g < 4; ++g) { u32x2 w; w.x = cvt_pk_bf16(o[db][4 * g] * linv, o[db][4 * g + 1] * linv); w.y = cvt_pk_bf16(o[db][4 * g + 2] * linv, o[db][4 * g + 3] * linv);
                    *(u32x2*)(op + db * 32 + 8 * g) = w; }
        }
    } else {
        LAS float* X = (LAS float*)lds + (size_t)qg * 64 * 64 + lane;
        if (s == 1 && active) {
#pragma unroll
            for (int db = 0; db < NDB; ++db)
#pragma unroll
                for (int r = 0; r < 16; ++r) X[(db * 16 + r) * 64] = o[db][r] * linv;
        }
        __syncthreads();
        if (s == 0 && active) {
            float ss = 0.f;
#pragma unroll
            for (int db = 0; db < NDB; ++db)
#pragma unroll
                for (int r = 0; r < 16; ++r) { const float v = o[db][r] * linv - lam * X[(db * 16 + r) * 64]; o[db][r] = v; ss += v * v; }
            ss += __shfl_xor(ss, 32);
            const float rstd = 0.8f / sqrtf(ss * (1.0f / 128.0f) + EPS);
            if (qrow < u.nq) {
                bf16_t* op = u.O + (size_t)qrow * u.ldo + 4 * hi;
#pragma unroll
                for (int db = 0; db < NDB; ++db)
#pragma unroll
                    for (int g = 0; g < 4; ++g) { const f32x4 sg = *(const f32x4*)(subg + db * 32 + 8 * g + 4 * hi);
                        u32x2 w; w.x = cvt_pk_bf16(o[db][4 * g] * rstd * sg[0], o[db][4 * g + 1] * rstd * sg[1]); w.y = cvt_pk_bf16(o[db][4 * g + 2] * rstd * sg[2], o[db][4 * g + 3] * rstd * sg[3]);
                        *(u32x2*)(op + db * 32 + 8 * g) = w; }
            }
        }
    }
}

__global__ void __launch_bounds__(512, 2) fwd_kernel(Args args) {
    extern __shared__ __attribute__((aligned(16))) unsigned char lds_raw[];
    LAS unsigned char* lds = (LAS unsigned char*)lds_raw;
    cg::grid_group grid = cg::this_grid();
    const int tid = threadIdx.x, lane = tid & 63, wave = __builtin_amdgcn_readfirstlane(tid >> 6);
    const int G = gridDim.x, bx = blockIdx.x;
    const int gw = bx * 8 + wave, NGW = G * 8;
    unsigned char* ws = args.ws; float* out = args.out;
    unsigned* ctl = (unsigned*)(ws + WS_CTL);
#define x_p (args.in[0])
#define x_s (args.in[1])
#define cak (args.in[2])
#define cav (args.in[3])
#define cbk (args.in[4])
#define cbv (args.in[5])
#define cmk (args.in[6])
#define cmv (args.in[7])
#define memp (args.in[8])
#define b_gate (args.in[11])
#define rel_bias (args.in[12])
#define lam_qk (args.in[13])
#define subln (args.in[14])
#define ng (args.in[21])
#define W_UP1 ((bf16_t*)(ws + WS_UP1))
#define W_DN1 ((bf16_t*)(ws + WS_DN1))
#define W_ING ((bf16_t*)(ws + WS_ING))
#define W_BRA ((bf16_t*)(ws + WS_BRA))
#define W_BRB ((bf16_t*)(ws + WS_BRB))
#define W_OUT ((bf16_t*)(ws + WS_OUT))
#define W_MQ ((bf16_t*)(ws + WS_MQ))
#define W_MKV ((bf16_t*)(ws + WS_MKV))
#define W_MO ((bf16_t*)(ws + WS_MO))
#define W_UP2 ((bf16_t*)(ws + WS_UP2))
#define W_DN2 ((bf16_t*)(ws + WS_DN2))
#define MKB ((bf16_t*)(ws + WS_MKB))
#define MEMN ((bf16_t*)(ws + WS_MEMN))
#define XN ((bf16_t*)(ws + WS_XN))
#define ACT ((bf16_t*)(ws + WS_ACT))
#define DF ((float*)(ws + WS_DF))
#define H ((float*)(ws + WS_H))
#define QKV ((bf16_t*)(ws + WS_QKV))
#define GATES ((bf16_t*)(ws + WS_GATES))
#define YA ((bf16_t*)(ws + WS_YA))
#define YB ((bf16_t*)(ws + WS_YB))
#define MKS ((bf16_t*)(ws + WS_MKS))
#define QM QKV
#define OM ACT
#define VTA ACT
#define VTB (ACT + (size_t)NB * 512 * SEQ)
    const int lo = args.ph_lo, hi_ph = args.ph_hi;
#ifndef PH_MASK
#define PH_MASK 0xffffffffu
#endif
#define IN(k) ((((PH_MASK) >> (k)) & 1u) && lo <= (k) && (k) < hi_ph)
#define SEAM(k) do { if (IN(k) && IN((k) + 1)) grid.sync(); } while (0)
#define GEMM_PHASE(EPI, e, Aptr, Bptr, Mrows, Ncols, Kdim, cidx) do { pg8::Gemm g_{(const pg8::bf16_t*)(Aptr), (const pg8::bf16_t*)(Bptr), (Mrows), (Ncols), (Kdim)}; pg8::StaticOrder S_; S_.init((Mrows), (Ncols), G, (cidx)); \
        pg8::gemm_phase<EPI, pg8::StaticOrder, true, true>(lds, g_, S_, e); } while (0)

    if (IN(0)) {
        if (bx == 0 && tid < 64) ctl[tid] = 0u;
        LAS float* scr = (LAS float*)(lds + wave * 16384);
        constexpr int I_UP = 16 * (NUP / 32), I_DN = (DFF / 64) * 32, I_IN = 16 * (NIN / 32), I_GT = 16 * (NGATE / 32), I_BR = 8 * 32, I_SQ = 16 * 32, I_MKV = 16 * 64;
        constexpr int NITEMS = 2 * I_UP + 2 * I_DN + I_IN + I_GT + 2 * I_BR + 3 * I_SQ + I_MKV;
        for (int it = gw; it < NITEMS; it += NGW) {
            int r = it;
            if (r < I_UP) { transpose_item<true>(args.in[22], DM, NUP, W_UP1, 0, scr, r, lane); continue; } r -= I_UP;
            if (r < I_UP) { transpose_item<true>(args.in[24], DM, NUP, W_UP2, 0, scr, r, lane); continue; } r -= I_UP;
            if (r < I_DN) { transpose_item<false>(args.in[23], DFF, DM, W_DN1, 0, scr, r, lane); continue; } r -= I_DN;
            if (r < I_DN) { transpose_item<false>(args.in[25], DFF, DM, W_DN2, 0, scr, r, lane); continue; } r -= I_DN;
            if (r < I_IN) { transpose_item<false>(args.in[9], DM, NIN, W_ING, 0, scr, r, lane); continue; } r -= I_IN;
            if (r < I_GT) { transpose_item<false>(args.in[10], DM, NGATE, W_ING, NIN, scr, r, lane); continue; } r -= I_GT;
            if (r < I_BR) { transpose_item<false>(args.in[15], 512, DM, W_BRA, 0, scr, r, lane); continue; } r -= I_BR;
            if (r < I_BR) { transpose_item<false>(args.in[16], 512, DM, W_BRB, 0, scr, r, lane); continue; } r -= I_BR;
            if (r < I_SQ) { transpose_item<false>(args.in[17], DM, DM, W_OUT, 0, scr, r, lane); continue; } r -= I_SQ;
            if (r < I_SQ) { transpose_item<false>(args.in[18], DM, DM, W_MQ, 0, scr, r, lane); continue; } r -= I_SQ;
            if (r < I_SQ) { transpose_item<false>(args.in[20], DM, DM, W_MO, 0, scr, r, lane); continue; } r -= I_SQ;
            transpose_item<false>(args.in[19], DM, 2 * DM, W_MKV, 0, scr, r, lane);
        }
        for (int m = gw; m < MT + NB * MEMT; m += NGW) {
            if (m < MP) rms_row_to_bf16(x_p + (size_t)m * DM, ng, XN + (size_t)m * DM, lane);
            else if (m < MT) rms_row_to_bf16(x_s + (size_t)(m - MP) * DM, ng, XN + (size_t)m * DM, lane);
            else rms_row_to_bf16(memp + (size_t)(m - MT) * DM, ng + 6 * DM, MEMN + (size_t)(m - MT) * DM, lane);
        }
        for (int r = gw; r < 2 * DB * MEMT; r += NGW) {
            const int which = r / (DB * MEMT), rr = r % (DB * MEMT);
            const f32x4* src = (const f32x4*)((which ? cmv : cmk) + (size_t)rr * DM) + lane; u32x2* dst = (u32x2*)(MKS + (size_t)rr * 2048 + which * DM) + lane;
#pragma unroll
            for (int j = 0; j < 4; ++j) { const f32x4 v = src[64 * j]; u32x2 w; w.x = cvt_pk_bf16(v.x, v.y); w.y = cvt_pk_bf16(v.z, v.w); dst[64 * j] = w; }
        }
        for (int r = gw; r < 2 * DB * (LA - DS); r += NGW) {
            const int which = r / (DB * (LA - DS)), rr = r % (DB * (LA - DS)), n = rr / (LA - DS), j = rr % (LA - DS);
            const f32x4* src = (const f32x4*)((which ? cav : cak) + ((size_t)n * LA + j + DS) * 512) + lane;
            f32x4* dst = (f32x4*)(out + (which ? O_AVS : O_AKS) + ((size_t)n * LA + j) * 512) + lane;
            dst[0] = src[0]; dst[64] = src[64];
        }
    }
    SEAM(0);
    if (IN(1)) {
        { EpiSwiglu e{ACT}; GEMM_PHASE(EpiSwiglu, e, XN, W_UP1, MT, NUP, DM, bx); }
        { EpiMemKV e{out, MKB}; GEMM_PHASE(EpiMemKV, e, MEMN, W_MKV, NB * MEMT, 2 * DM, DM, G - 1 - bx); }
    }
    SEAM(1);
    if (IN(2)) { EpiF32 e{DF, DM}; GEMM_PHASE(EpiF32, e, ACT, W_DN1, MT, DM, DFF, bx); }
    SEAM(2);
    if (IN(3)) {
        for (int m = gw; m < MT; m += NGW) res_row<false>(m < MP ? x_p + (size_t)m * DM : x_s + (size_t)(m - MP) * DM, DF + (size_t)m * DM, ng + 1 * DM, 0.5f, H + (size_t)m * DM, ng + 2 * DM, XN + (size_t)m * DM, lane);
    }
    SEAM(3);
    if (IN(4)) { EpiInGate e{QKV, GATES, b_gate, out, VTA, VTB}; GEMM_PHASE(EpiInGate, e, XN, W_ING, MT, NING, DM, bx); }
    SEAM(4);
    if (IN(5)) {
        float lam;
        { const float a = lam_qk[lane] * lam_qk[64 + lane], b = lam_qk[128 + lane] * lam_qk[192 + lane]; lam = expf(wave_sum(a)) - expf(wave_sum(b)) + 0.2f; }
        constexpr int N_SD = DB * 4, N_SB = DB * 4, N_PD = NB * 4 * 128, N_PB = NB * 4 * 128;
        volatile LAS unsigned* qw = (volatile LAS unsigned*)(lds + LDS_QW);
#ifndef REP5
#define REP5 1
#endif
        for (int rep = 0; rep < REP5; ++rep) {
        for (;;) {
            __syncthreads();
            if (tid == 0) qw[0] = atomicAdd(&ctl[4 + 2 * rep], 1u);
            __syncthreads();
            const int idx = __builtin_amdgcn_readfirstlane((int)qw[0]);
            if (idx >= N_SD + N_SB) break;
            AUnit u;
            if (idx < N_SD) {
                const int n = idx >> 2, h = idx & 3; const size_t row0 = MP + (size_t)n * DS;
                u.Q = QKV + row0 * NIN + 1536 + h * 128; u.ldq = NIN; u.nq = DS; u.qpos0 = PAST;
                u.K0 = cbk + (size_t)n * PAST * 512 + h * 128; u.V0 = cbv + (size_t)n * PAST * 512 + h * 128; u.ld0 = 512; u.nt0 = PAST / 64;
                u.K1 = out + O_BKS + (size_t)n * DS * 512 + h * 128; u.V1 = out + O_BVS + (size_t)n * DS * 512 + h * 128; u.ld1 = 512; u.ldv1 = 0; u.n1 = DS;
                u.kpos0 = 0; u.tb = 0; u.te = PAST / 64 + 1; u.nkeys = PAST + DS; u.head = h; u.O = YB + row0 * 512 + h * 128; u.ldo = 512;
                attn_unit<1, true>(lds, u, lam, rel_bias, subln);
            } else {
                const int j = idx - N_SD, n = j >> 2, hp = j & 3; const size_t row0 = MP + (size_t)n * DS;
                u.Q = QKV + row0 * NIN + hp * 128; u.ldq = NIN; u.nq = DS; u.qpos0 = PAST;
                u.K0 = cak + (size_t)n * LA * 512 + hp * 128; u.V0 = cav + (size_t)n * LA * 512 + hp * 128; u.ld0 = 512; u.nt0 = LA / 64;
                u.K1 = out + O_AKS + ((size_t)n * LA + (LA - DS)) * 512 + hp * 128; u.V1 = out + O_AVS + ((size_t)n * LA + (LA - DS)) * 512 + hp * 128; u.ld1 = 512; u.ldv1 = 0; u.n1 = DS;
                u.kpos0 = PAST - LA; u.tb = 1; u.te = LA / 64 + 1; u.nkeys = LA + DS; u.head = 2 * hp; u.O = YA + row0 * 512 + hp * 128; u.ldo = 512;
                attn_unit<0, true>(lds, u, lam, rel_bias, subln);
            }
        }
        for (;;) {
            __syncthreads();
            if (tid == 0) qw[0] = atomicAdd(&ctl[5 + 2 * rep], 1u);
            __syncthreads();
            const int idx = __builtin_amdgcn_readfirstlane((int)qw[0]);
            if (idx >= N_PD + N_PB) break;
            AUnit u;
            if (idx < N_PD) {
                const int j = idx, qb = 127 - (j >> 3), n = (j >> 2) & 1, h = j & 3; const size_t row0 = (size_t)n * SEQ + 128 * qb;
                u.Q = QKV + row0 * NIN + 1536 + h * 128; u.ldq = NIN; u.nq = 128; u.qpos0 = 128 * qb;
                u.K0 = nullptr; u.V0 = nullptr; u.ld0 = 0; u.nt0 = 0;
                u.K1 = QKV + (size_t)n * SEQ * NIN + 2048 + h * 128; u.V1 = VTB + ((size_t)n * 512 + h * 128) * SEQ; u.ld1 = NIN; u.ldv1 = SEQ; u.n1 = 0x7fffffff;
                u.kpos0 = 0; u.tb = 0; u.te = 2 * qb + 2; u.nkeys = 0x7fffffff; u.head = h; u.O = YB + row0 * 512 + h * 128; u.ldo = 512;
                attn_unit<1, false>(lds, u, lam, rel_bias, subln);
            } else {
                const int j = idx - N_PD, qb = 127 - (j >> 3), n = (j >> 2) & 1, hp = j & 3; const size_t row0 = (size_t)n * SEQ + 128 * qb;
                u.Q = QKV + row0 * NIN + hp * 128; u.ldq = NIN; u.nq = 128; u.qpos0 = 128 * qb;
                u.K0 = nullptr; u.V0 = nullptr; u.ld0 = 0; u.nt0 = 0;
                u.K1 = QKV + (size_t)n * SEQ * NIN + 512 + hp * 128; u.V1 = VTA + ((size_t)n * 512 + hp * 128) * SEQ; u.ld1 = NIN; u.ldv1 = SEQ; u.n1 = 0x7fffffff;
                u.kpos0 = 0; u.tb = (2 * qb - 8 > 0) ? 2 * qb - 8 : 0; u.te = 2 * qb + 2; u.nkeys = 0x7fffffff; u.head = 2 * hp; u.O = YA + row0 * 512 + hp * 128; u.ldo = 512;
                attn_unit<0, false>(lds, u, lam, rel_bias, subln);
            }
        }
        }
    }
    SEAM(5);
    if (IN(6)) { EpiBrA e{GATES, DF}; GEMM_PHASE(EpiBrA, e, YA, W_BRA, MT, DM, 512, bx); }
    SEAM(6);
    if (IN(7)) { EpiBrB e{GATES, DF, XN}; GEMM_PHASE(EpiBrB, e, YB, W_BRB, MT, DM, 512, bx); }
    SEAM(7);
    if (IN(8)) { EpiF32 e{DF, DM}; GEMM_PHASE(EpiF32, e, XN, W_OUT, MT, DM, DM, bx); }
    SEAM(8);
    if (IN(9)) { for (int m = gw; m < MT; m += NGW) res_row<false>(H + (size_t)m * DM, DF + (size_t)m * DM, ng + 3 * DM, 1.0f, H + (size_t)m * DM, ng + 4 * DM, XN + (size_t)m * DM, lane); }
    SEAM(9);
    if (IN(10)) { EpiBf16 e{QM, DM}; GEMM_PHASE(EpiBf16, e, XN, W_MQ, MT, DM, DM, bx); }
    SEAM(10);
    if (IN(11)) {
        constexpr int N_S = DB * 4, N_P = NB * 4 * 128, N_ALL = N_S + N_P;
        volatile LAS unsigned* qw = (volatile LAS unsigned*)(lds + LDS_QW);
        for (;;) {
            __syncthreads();
            if (tid == 0) qw[0] = atomicAdd(&ctl[1], 1u);
            __syncthreads();
            const int idx = __builtin_amdgcn_readfirstlane((int)qw[0]);
            if (idx >= N_ALL) break;
            AUnit u; u.ldv1 = 0; u.qpos0 = 0; u.kpos0 = 0; u.tb = 0; u.te = MEMT / 64; u.nkeys = 0x7fffffff; u.ldq = DM; u.ldo = DM;
            if (idx < N_S) {
                const int n = idx >> 2, h = idx & 3; const size_t row0 = MP + (size_t)n * DS;
                u.Q = QM + row0 * DM + h * 256; u.nq = DS; u.head = h;
                u.K0 = nullptr; u.V0 = nullptr; u.ld0 = 0; u.nt0 = 0;
                u.K1 = MKS + (size_t)n * MEMT * 2048 + h * 256; u.V1 = MKS + (size_t)n * MEMT * 2048 + DM + h * 256; u.ld1 = 2048; u.n1 = 0x7fffffff; u.O = OM + row0 * DM + h * 256;
                attn_unit<2, false>(lds, u, 0.f, rel_bias, subln);
            } else {
                const int j = idx - N_S, qb = j >> 3, n = (j >> 2) & 1, h = j & 3; const size_t row0 = (size_t)n * SEQ + 128 * qb;
                u.Q = QM + row0 * DM + h * 256; u.nq = 128; u.head = h;
                u.K0 = nullptr; u.V0 = nullptr; u.ld0 = 0; u.nt0 = 0;
                u.K1 = MKB + (size_t)n * MEMT * 2048 + h * 256; u.V1 = MKB + (size_t)n * MEMT * 2048 + DM + h * 256; u.ld1 = 2048; u.n1 = 0x7fffffff; u.O = OM + row0 * DM + h * 256;
                attn_unit<2, false>(lds, u, 0.f, rel_bias, subln);
            }
        }
    }
    SEAM(11);
    if (IN(12)) { EpiF32 e{DF, DM}; GEMM_PHASE(EpiF32, e, OM, W_MO, MT, DM, DM, bx); }
    SEAM(12);
    if (IN(13)) { for (int m = gw; m < MT; m += NGW) res_row<false>(H + (size_t)m * DM, DF + (size_t)m * DM, ng + 5 * DM, 1.0f, H + (size_t)m * DM, ng + 7 * DM, XN + (size_t)m * DM, lane); }
    SEAM(13);
    if (IN(14)) { EpiSwiglu e{ACT}; GEMM_PHASE(EpiSwiglu, e, XN, W_UP2, MT, NUP, DM, bx); }
    SEAM(14);
    if (IN(15)) { EpiF32 e{DF, DM}; GEMM_PHASE(EpiF32, e, ACT, W_DN2, MT, DM, DFF, bx); }
    SEAM(15);
    if (IN(16)) { for (int m = gw; m < MT; m += NGW) res_row<true>(H + (size_t)m * DM, DF + (size_t)m * DM, ng + 8 * DM, 0.5f, out + O_YP + (size_t)m * DM, nullptr, nullptr, lane); }
#undef IN
#undef SEAM
#undef GEMM_PHASE
}
constexpr int N_PHASES = 17;

extern "C" void kernel_launch(void* const* d_in, const int* in_sizes, int n_in, void* d_out, int out_size, void* d_ws, size_t ws_size, hipStream_t stream) {
    static int grid = 0;
    if (grid == 0) {
        if (n_in != 26 || (size_t)out_size != O_END || ws_size < WS_END) { fprintf(stderr, "kernel_launch: unexpected shapes: n_in %d out %d (want %zu) ws %zu (want %zu)\n", n_in, out_size, (size_t)O_END, ws_size, (size_t)WS_END); grid = -1; return; }
        int dev = 0, cus = 0, per_cu = 0;
        hipGetDevice(&dev); hipDeviceGetAttribute(&cus, hipDeviceAttributeMultiprocessorCount, dev);
        if (hipFuncSetAttribute((const void*)fwd_kernel, hipFuncAttributeMaxDynamicSharedMemorySize, LDS_BYTES) != hipSuccess) { fprintf(stderr, "kernel_launch: hipFuncSetAttribute failed\n"); grid = -1; return; }
        if (hipOccupancyMaxActiveBlocksPerMultiprocessor(&per_cu, (const void*)fwd_kernel, 512, LDS_BYTES) != hipSuccess || per_cu < 1) { fprintf(stderr, "kernel_launch: occupancy query says %d\n", per_cu); per_cu = 1; }
        (void)hipGetLastError();
        grid = cus * 1;
        if (grid <= 0) grid = 256;
    }
    if (grid < 0) return;
    (void)hipMemsetAsync((char*)d_ws + WS_CTL, 0, 4096, stream);
    Args a{};
    for (int i = 0; i < 26; ++i) a.in[i] = (const float*)d_in[i];
    a.out = (float*)d_out; a.ws = (unsigned char*)d_ws;
#if MK_MULTI
    for (int p = 0; p < N_PHASES; ++p) { a.ph_lo = p; a.ph_hi = p + 1; hipLaunchKernelGGL(fwd_kernel, dim3(grid), dim3(512), LDS_BYTES, stream, a); }
#else
    a.ph_lo = 0; a.ph_hi = N_PHASES;
    void* kargs[] = {&a};
    hipError_t e = hipLaunchCooperativeKernel((const void*)fwd_kernel, dim3(grid), dim3(512), kargs, LDS_BYTES, stream);
    if (e != hipSuccess) fprintf(stderr, "kernel_launch: cooperative launch failed: %s (grid %d)\n", hipGetErrorString(e), grid);
#endif
}
```

```cpp
#include <hip/hip_runtime.h>
#include <hip/hip_cooperative_groups.h>
#include <cstdio>
#include <cstdint>
namespace cg = cooperative_groups;
#ifndef MK_MULTI
#define MK_MULTI 0
#endif
namespace pg8 {
#define PG8_LAS __attribute__((address_space(3)))
typedef unsigned short bf16_t;
typedef short bf16x8 __attribute__((ext_vector_type(8)));
typedef float f32x4 __attribute__((ext_vector_type(4)));
typedef unsigned u32x4 __attribute__((ext_vector_type(4)));
constexpr int BM = 256, BK = 64, HALF = 128, HTB = HALF * BK * 2  , STAGE_BYTES = 8 * HTB, NXCD = 8, WGM = 8;

__host__ __device__ __forceinline__ int lds_byte(int r, int c) { const int st = (r >> 4) * 2 + (c >> 5), rr = r & 15, cc = c & 31, ob = rr * 64 + cc * 2; return st * 1024 + (ob ^ (((ob >> 9) & 1) << 5)); }
__host__ __device__ __forceinline__ void stage_rc(int b, int& R, int& C) { const int st = b / 1024, sb = b % 1024, swz = sb ^ (((sb >> 9) & 1) << 5); R = (st >> 1) * 16 + swz / 64; C = (st & 1) * 32 + (swz % 64) / 2; }
__host__ __device__ __forceinline__ int perm32(int rho) { const int n = rho >> 4, i = rho & 15; return 8 * (i >> 2) + 4 * n + (i & 3); }

struct Unit { int pm, pn; };
struct Gemm { const bf16_t* A; const bf16_t* Bt; int M, N, K; };

struct StaticOrder {
    int nM, nN, nwg, G, c;
    __host__ __device__ void init(int M, int N, int G_, int c_) { nM = M / BM; nN = N / BM; nwg = nM * nN; G = G_; c = c_; }
    __host__ __device__ bool next(int i, Unit& u) const {
        const long L = (long)i * G + c; if (L >= nwg) return false;
        int wgid = (int)L; { const int q = nwg / NXCD, r = nwg % NXCD, xcd = wgid % NXCD, off = wgid / NXCD; wgid = (xcd < r ? xcd * (q + 1) : r * (q + 1) + (xcd - r) * q) + off; }
        const int nig = WGM * nN, gid = wgid / nig, fm = gid * WGM, gsz = (nM - fm) < WGM ? (nM - fm) : WGM;
        u.pm = fm + ((wgid % nig) % gsz); u.pn = (wgid % nig) / gsz; return true;
    }
    __device__ __forceinline__ void a_ready(const Unit&) const {}
    __device__ __forceinline__ void done(const Unit&) const {}
};

__device__ __forceinline__ unsigned cvt_pk_bf16(float lo, float hi) { unsigned r; asm volatile("v_cvt_pk_bf16_f32 %0, %1, %2" : "=v"(r) : "v"(lo), "v"(hi)); return r; }
typedef float f32x2 __attribute__((ext_vector_type(2)));
template <class Epi, class Sched, bool ALIGN_EPI = false, bool SP2 = false>
__device__ __forceinline__ void gemm_phase(PG8_LAS unsigned char* lds, const Gemm g, const Sched& S, const Epi& E) {
    const int tid = threadIdx.x, wid = __builtin_amdgcn_readfirstlane(tid >> 6), lane = tid & 63, wr = wid >> 2, wc = wid & 3, fr = lane & 15, fq = lane >> 4;
    const int K = g.K, nt = K / BK;
    unsigned voffA[2], voffB[2];
#pragma unroll
    for (int i = 0; i < 2; ++i) { int R, C; stage_rc(tid * 16 + i * 8192, R, C); const int Rb = Epi::PERM ? ((R & ~31) + perm32(R & 31)) : R;
        voffA[i] = (unsigned)(R * K + C) * 2u; voffB[i] = (unsigned)(Rb * K + C) * 2u; }
    const size_t kstep = (size_t)(BK * 2);
    const size_t hstep = (size_t)HALF * K * 2;
    const size_t tstep = 2 * hstep;
    const unsigned ldsw = (unsigned)wid * 1024u;
    const int aoff = lds_byte(wr * 64 + fr, fq * 8), boff = lds_byte(wc * 32 + fr, fq * 8);
#define PG8_SA(b, h) (((b) * 2 + (h)) * HTB)
#define PG8_SB(b, h) ((4 + (b) * 2 + (h)) * HTB)
#define PG8_STAGE(bufoff, gbase, voff) do { _Pragma("unroll") for (int _i = 0; _i < 2; ++_i) \
        __builtin_amdgcn_global_load_lds((const unsigned*)((const char*)(gbase) + (voff)[_i]), (PG8_LAS unsigned*)(lds + (bufoff) + ldsw + _i * 8192), 16, 0, 0); } while (0)
#define PG8_LDA(dst, b, h) do { _Pragma("unroll") for (int m = 0; m < 4; ++m) _Pragma("unroll") for (int k = 0; k < 2; ++k) dst[m][k] = *(const PG8_LAS bf16x8*)(lds + PG8_SA(b, h) + aoff + m * 2048 + k * 1024); } while (0)
#define PG8_LDB(dst, b, h) do { _Pragma("unroll") for (int n = 0; n < 2; ++n) _Pragma("unroll") for (int k = 0; k < 2; ++k) dst[n][k] = *(const PG8_LAS bf16x8*)(lds + PG8_SB(b, h) + boff + n * 2048 + k * 1024); } while (0)
#define PG8_MMA(ai, bj, At, Bt) do { __builtin_amdgcn_s_setprio(1); _Pragma("unroll") for (int m = 0; m < 4; ++m) _Pragma("unroll") for (int n = 0; n < 2; ++n) _Pragma("unroll") for (int k = 0; k < 2; ++k) \
        acc[ai][bj][m][n] = __builtin_amdgcn_mfma_f32_16x16x32_bf16(Bt[n][k], At[m][k], acc[ai][bj][m][n], 0, 0, 0); __builtin_amdgcn_s_setprio(0); } while (0)
#define PG8_WAIT_V(n) asm volatile("s_waitcnt vmcnt(" #n ")" ::: "memory")
#define PG8_WAIT_L(n) asm volatile("s_waitcnt lgkmcnt(" #n ")" ::: "memory")
#define PG8_BAR __builtin_amdgcn_s_barrier()
#define PG8_SCHED __builtin_amdgcn_sched_barrier(0)
    Unit cur, nxt; int ui = 0;
    if (!S.next(0, cur)) return;
    f32x4 acc[2][2][4][2];
#pragma unroll
    for (int a = 0; a < 2; ++a)
#pragma unroll
        for (int b = 0; b < 2; ++b)
#pragma unroll
            for (int m = 0; m < 4; ++m)
#pragma unroll
                for (int n = 0; n < 2; ++n) acc[a][b][m][n] = (f32x4){0.f, 0.f, 0.f, 0.f};
    bf16x8 At[4][2], B0[2][2], B1[2][2];
    const char* cA = (const char*)g.A + (size_t)cur.pm * tstep; const char* cB = (const char*)g.Bt + (size_t)cur.pn * tstep;
    S.a_ready(cur);
    if constexpr (SP2) {
        PG8_STAGE(PG8_SB(0, 0), cB, voffB); PG8_STAGE(PG8_SB(0, 1), cB + hstep, voffB); PG8_STAGE(PG8_SA(0, 0), cA, voffA); PG8_STAGE(PG8_SA(0, 1), cA + hstep, voffA);
        if (wr == 1) PG8_BAR;
        PG8_WAIT_V(2); PG8_BAR;
        PG8_STAGE(PG8_SB(1, 0), cB + kstep, voffB); PG8_STAGE(PG8_SA(1, 0), cA + kstep, voffA); PG8_STAGE(PG8_SB(1, 1), cB + hstep + kstep, voffB);
        PG8_WAIT_V(6); PG8_BAR;
    } else {
        PG8_STAGE(PG8_SB(0, 0), cB, voffB); PG8_STAGE(PG8_SA(0, 0), cA, voffA); PG8_STAGE(PG8_SB(0, 1), cB + hstep, voffB); PG8_STAGE(PG8_SA(0, 1), cA + hstep, voffA);
        if (wr == 1) PG8_BAR;
        PG8_WAIT_V(4); PG8_BAR;
        PG8_STAGE(PG8_SB(1, 0), cB + kstep, voffB); PG8_STAGE(PG8_SA(1, 0), cA + kstep, voffA); PG8_STAGE(PG8_SB(1, 1), cB + hstep + kstep, voffB);
        PG8_WAIT_V(6); PG8_BAR;
    }
    for (;;) {
        const bool has_next = S.next(ui + 1, nxt);
        const char* nA = has_next ? (const char*)g.A + (size_t)nxt.pm * tstep : cA; const char* nB = has_next ? (const char*)g.Bt + (size_t)nxt.pn * tstep : cB;
        for (int t = 0; t < nt; t += 2) {
            const bool last = (t == nt - 2);
            const char* a1 = cA + (size_t)(t + 1) * kstep;
            const char* a2 = last ? nA : cA + (size_t)(t + 2) * kstep; const char* b2 = last ? nB : cB + (size_t)(t + 2) * kstep;
            const char* a3 = a2 + kstep; const char* b3 = b2 + kstep;
            if (last && has_next) S.a_ready(nxt);
            if constexpr (SP2) {
            PG8_LDB(B0, 0, 0); PG8_LDB(B1, 0, 1); PG8_SCHED; PG8_LDA(At, 0, 0); PG8_STAGE(PG8_SA(1, 1), a1 + hstep, voffA);
            PG8_WAIT_V(8); PG8_WAIT_L(0); PG8_BAR; PG8_MMA(0, 0, At, B0); PG8_MMA(0, 1, At, B1); PG8_BAR; PG8_SCHED;
            PG8_LDA(At, 0, 1); PG8_STAGE(PG8_SB(0, 0), b2, voffB); PG8_STAGE(PG8_SB(0, 1), b2 + hstep, voffB); PG8_STAGE(PG8_SA(0, 0), a2, voffA);
            PG8_WAIT_V(8); PG8_WAIT_L(0); PG8_BAR; PG8_MMA(1, 0, At, B0); PG8_MMA(1, 1, At, B1); PG8_BAR; PG8_SCHED;
            PG8_LDB(B0, 1, 0); PG8_LDB(B1, 1, 1); PG8_SCHED; PG8_LDA(At, 1, 0); PG8_STAGE(PG8_SA(0, 1), a2 + hstep, voffA);
            PG8_WAIT_V(8); PG8_WAIT_L(0); PG8_BAR; PG8_MMA(0, 0, At, B0); PG8_MMA(0, 1, At, B1); PG8_BAR; PG8_SCHED;
            PG8_LDA(At, 1, 1); PG8_STAGE(PG8_SB(1, 0), b3, voffB); PG8_STAGE(PG8_SB(1, 1), b3 + hstep, voffB); PG8_STAGE(PG8_SA(1, 0), a3, voffA);
            PG8_WAIT_V(8); PG8_WAIT_L(0); PG8_BAR; PG8_MMA(1, 0, At, B0); PG8_MMA(1, 1, At, B1); PG8_BAR; PG8_SCHED;
            } else {
            PG8_LDB(B0, 0, 0); PG8_SCHED; PG8_LDA(At, 0, 0); PG8_STAGE(PG8_SA(1, 1), a1 + hstep, voffA);
            PG8_WAIT_L(8); PG8_BAR; PG8_WAIT_L(0); PG8_MMA(0, 0, At, B0); PG8_BAR; PG8_SCHED;
            PG8_LDB(B1, 0, 1); PG8_STAGE(PG8_SB(0, 0), b2, voffB);
            PG8_BAR; PG8_WAIT_L(0); PG8_MMA(0, 1, At, B1); PG8_BAR;
            PG8_LDA(At, 0, 1); PG8_STAGE(PG8_SA(0, 0), a2, voffA);
            PG8_BAR; PG8_WAIT_L(0); PG8_MMA(1, 0, At, B0); PG8_BAR; PG8_SCHED;
            PG8_STAGE(PG8_SB(0, 1), b2 + hstep, voffB);
            PG8_WAIT_V(6); PG8_BAR; PG8_MMA(1, 1, At, B1); PG8_BAR;
            PG8_LDB(B0, 1, 0); PG8_SCHED; PG8_LDA(At, 1, 0); PG8_STAGE(PG8_SA(0, 1), a2 + hstep, voffA);
            PG8_WAIT_L(8); PG8_BAR; PG8_WAIT_L(0); PG8_MMA(0, 0, At, B0); PG8_BAR; PG8_SCHED;
            PG8_LDB(B1, 1, 1); PG8_STAGE(PG8_SB(1, 0), b3, voffB);
            PG8_BAR; PG8_WAIT_L(0); PG8_MMA(0, 1, At, B1); PG8_BAR;
            PG8_LDA(At, 1, 1); PG8_STAGE(PG8_SA(1, 0), a3, voffA);
            PG8_BAR; PG8_WAIT_L(0); PG8_MMA(1, 0, At, B0); PG8_BAR; PG8_SCHED;
            PG8_STAGE(PG8_SB(1, 1), b3 + hstep, voffB);
            PG8_WAIT_V(6); PG8_BAR; PG8_MMA(1, 1, At, B1); PG8_BAR;
            }
        }
        if constexpr (ALIGN_EPI) { if (wr == 0) PG8_BAR; }
        if constexpr (!Epi::AFTER_DRAIN) { E(acc, cur, wr, wc, fr, fq); S.done(cur); }
        if (!has_next) break;
#pragma unroll
        for (int a = 0; a < 2; ++a)
#pragma unroll
            for (int b = 0; b < 2; ++b)
#pragma unroll
                for (int m = 0; m < 4; ++m)
#pragma unroll
                    for (int n = 0; n < 2; ++n) acc[a][b][m][n] = (f32x4){0.f, 0.f, 0.f, 0.f};
        cur = nxt; cA = nA; cB = nB; ++ui;
        if constexpr (ALIGN_EPI) { if (wr == 1) PG8_BAR; }
    }
    PG8_WAIT_V(0);
    if constexpr (!ALIGN_EPI) { if (wr == 0) PG8_BAR; }
    PG8_BAR;
    if constexpr (Epi::AFTER_DRAIN) { E.fused(acc, cur, wr, wc, fr, fq, lds, wid, lane); S.done(cur); }
#undef PG8_SA
#undef PG8_SB
#undef PG8_STAGE
#undef PG8_LDA
#undef PG8_LDB
#undef PG8_MMA
#undef PG8_WAIT_V
#undef PG8_WAIT_L
#undef PG8_BAR
#undef PG8_SCHED
}
}

#define LAS __attribute__((address_space(3)))
typedef unsigned short bf16_t;
typedef short bf16x8 __attribute__((ext_vector_type(8)));
typedef short s16x4 __attribute__((ext_vector_type(4)));
typedef float f32x4 __attribute__((ext_vector_type(4)));
typedef float f32x16 __attribute__((ext_vector_type(16)));
typedef unsigned u32x4 __attribute__((ext_vector_type(4)));
typedef unsigned u32x2 __attribute__((ext_vector_type(2)));
typedef float f32x2_t __attribute__((ext_vector_type(2))); typedef __bf16 bf16x2_t __attribute__((ext_vector_type(2)));
__device__ __forceinline__ unsigned cvt_pk_bf16(float lo, float hi) { f32x2_t v = {lo, hi}; bf16x2_t b = __builtin_convertvector(v, bf16x2_t); return __builtin_bit_cast(unsigned, b); }

constexpr int DM = 1024, SEQ = 16384, NB = 2, DB = 32, DS = 16, PAST = 4096, LA = 576;
constexpr int MP = NB * SEQ, MS = DB * DS, MT = MP + MS;
constexpr int DFF = 2816, NUP = 2 * DFF, NIN = 3072, NGATE = 2048, NING = NIN + NGATE, MEMT = 256;
constexpr float EPS = 1e-6f, LOG2E = 1.4426950408889634f;
static_assert(MT % 256 == 0, "rows");

constexpr size_t O_YP = 0, O_YS = O_YP + (size_t)MP * DM, O_AKP = O_YS + (size_t)MS * DM, O_AVP = O_AKP + (size_t)NB * LA * 512,
    O_BKP = O_AVP + (size_t)NB * LA * 512, O_BVP = O_BKP + (size_t)MP * 512, O_MKP = O_BVP + (size_t)MP * 512, O_MVP = O_MKP + (size_t)NB * MEMT * DM,
    O_AKS = O_MVP + (size_t)NB * MEMT * DM, O_AVS = O_AKS + (size_t)DB * LA * 512, O_BKS = O_AVS + (size_t)DB * LA * 512, O_BVS = O_BKS + (size_t)MS * 512,
    O_END = O_BVS + (size_t)MS * 512;

constexpr size_t MiB = 1u << 20;
constexpr size_t WS_CTL = 0;
constexpr size_t WS_UP1 = 1 * MiB, WS_DN1 = WS_UP1 + 11 * MiB, WS_ING = WS_DN1 + 6 * MiB, WS_BRA = WS_ING + 10 * MiB, WS_BRB = WS_BRA + 1 * MiB,
    WS_OUT = WS_BRB + 1 * MiB, WS_MQ = WS_OUT + 2 * MiB, WS_MKV = WS_MQ + 2 * MiB, WS_MO = WS_MKV + 4 * MiB, WS_UP2 = WS_MO + 2 * MiB, WS_DN2 = WS_UP2 + 11 * MiB,
    WS_MKB = WS_DN2 + 6 * MiB, WS_MEMN = WS_MKB + 2 * MiB, WS_XN = WS_MEMN + 1 * MiB, WS_ACT = WS_XN + 65 * MiB, WS_DF = WS_ACT + 179 * MiB,
    WS_H = WS_DF + 130 * MiB, WS_QKV = WS_H + 130 * MiB, WS_GATES = WS_QKV + 195 * MiB, WS_YA = WS_GATES + 130 * MiB, WS_YB = WS_YA + 33 * MiB, WS_MKS = WS_YB + 33 * MiB, WS_END = WS_MKS + 32 * MiB;
static_assert(WS_END <= 1024 * MiB, "workspace map");

constexpr int LDS_BYTES = 147456;
constexpr int LDS_QW = 140 * 1024;

struct Args { const float* in[26]; float* out; unsigned char* ws; int ph_lo, ph_hi; };

__device__ __forceinline__ float bf_lo(unsigned u) { return __uint_as_float(u << 16); }
__device__ __forceinline__ float bf_hi(unsigned u) { return __uint_as_float(u & 0xffff0000u); }
__device__ __forceinline__ float wave_sum(float v) {
#pragma unroll
    for (int o = 1; o < 64; o <<= 1) v += __shfl_xor(v, o);
    return v;
}
__device__ __forceinline__ u32x4 pack8(const float* v) {
    u32x4 w; w.x = cvt_pk_bf16(v[0], v[1]); w.y = cvt_pk_bf16(v[2], v[3]); w.z = cvt_pk_bf16(v[4], v[5]); w.w = cvt_pk_bf16(v[6], v[7]); return w;
}

#define EPI_ROWS_BEGIN _Pragma("unroll") for (int ai = 0; ai < 2; ++ai) _Pragma("unroll") for (int m = 0; m < 4; ++m) { const int row = u.pm * 256 + ai * 128 + wr * 64 + m * 16 + fr;
#define EPI_ROWS_END }
#define EPI_V8(bj) float v[8]; { const f32x4 a0 = acc[ai][bj][m][0], a1 = acc[ai][bj][m][1]; v[0] = a0[0]; v[1] = a0[1]; v[2] = a0[2]; v[3] = a0[3]; v[4] = a1[0]; v[5] = a1[1]; v[6] = a1[2]; v[7] = a1[3]; }
typedef const f32x4 (&AccRef)[2][2][4][2];

struct EpiSwiglu {
    static constexpr bool PERM = true, AFTER_DRAIN = false; bf16_t* O;
    __device__ __forceinline__ void operator()(AccRef acc, const pg8::Unit& u, int wr, int wc, int fr, int fq) const {
        const int col = u.pn * 128 + wc * 32 + 8 * fq;
        EPI_ROWS_BEGIN
            float o[8];
#pragma unroll
            for (int n = 0; n < 2; ++n)
#pragma unroll
                for (int i = 0; i < 4; ++i) { const float g = acc[ai][0][m][n][i], up = acc[ai][1][m][n][i];
                    const float sg = g * __builtin_amdgcn_rcpf(1.0f + __builtin_amdgcn_exp2f(-g * LOG2E)); o[n * 4 + i] = sg * up; }
            *(u32x4*)(O + (size_t)row * DFF + col) = pack8(o);
        EPI_ROWS_END
    }
};
struct EpiF32 {
    static constexpr bool PERM = true, AFTER_DRAIN = false; float* O; int ldc;
    __device__ __forceinline__ void operator()(AccRef acc, const pg8::Unit& u, int wr, int wc, int fr, int fq) const {
        EPI_ROWS_BEGIN
#pragma unroll
            for (int bj = 0; bj < 2; ++bj) { float* p = O + (size_t)row * ldc + u.pn * 256 + bj * 128 + wc * 32 + 8 * fq;
                *(f32x4*)p = acc[ai][bj][m][0]; *(f32x4*)(p + 4) = acc[ai][bj][m][1]; }
        EPI_ROWS_END
    }
};
struct EpiBf16 {
    static constexpr bool PERM = true, AFTER_DRAIN = false; bf16_t* O; int ldc;
    __device__ __forceinline__ void operator()(AccRef acc, const pg8::Unit& u, int wr, int wc, int fr, int fq) const {
        EPI_ROWS_BEGIN
#pragma unroll
            for (int bj = 0; bj < 2; ++bj) { EPI_V8(bj); *(u32x4*)(O + (size_t)row * ldc + u.pn * 256 + bj * 128 + wc * 32 + 8 * fq) = pack8(v); }
        EPI_ROWS_END
    }
};
struct EpiBrA {
    static constexpr bool PERM = true, AFTER_DRAIN = false; const bf16_t* G; float* T;
    __device__ __forceinline__ void operator()(AccRef acc, const pg8::Unit& u, int wr, int wc, int fr, int fq) const {
        EPI_ROWS_BEGIN
#pragma unroll
            for (int bj = 0; bj < 2; ++bj) { const int col = u.pn * 256 + bj * 128 + wc * 32 + 8 * fq; EPI_V8(bj);
                const u32x4 g = *(const u32x4*)(G + (size_t)row * NGATE + col);
                f32x4 o0, o1; o0[0] = v[0] * bf_lo(g.x); o0[1] = v[1] * bf_hi(g.x); o0[2] = v[2] * bf_lo(g.y); o0[3] = v[3] * bf_hi(g.y);
                o1[0] = v[4] * bf_lo(g.z); o1[1] = v[5] * bf_hi(g.z); o1[2] = v[6] * bf_lo(g.w); o1[3] = v[7] * bf_hi(g.w);
                float* p = T + (size_t)row * DM + col; *(f32x4*)p = o0; *(f32x4*)(p + 4) = o1; }
        EPI_ROWS_END
    }
};
struct EpiBrB {
    static constexpr bool PERM = true, AFTER_DRAIN = false; const bf16_t* G; const float* T; bf16_t* O;
    __device__ __forceinline__ void operator()(AccRef acc, const pg8::Unit& u, int wr, int wc, int fr, int fq) const {
        EPI_ROWS_BEGIN
#pragma unroll
            for (int bj = 0; bj < 2; ++bj) { const int col = u.pn * 256 + bj * 128 + wc * 32 + 8 * fq; EPI_V8(bj);
                const u32x4 g = *(const u32x4*)(G + (size_t)row * NGATE + DM + col);
                const float* p = T + (size_t)row * DM + col; const f32x4 t0 = *(const f32x4*)p, t1 = *(const f32x4*)(p + 4);
                float o[8]; o[0] = t0[0] + v[0] * bf_lo(g.x); o[1] = t0[1] + v[1] * bf_hi(g.x); o[2] = t0[2] + v[2] * bf_lo(g.y); o[3] = t0[3] + v[3] * bf_hi(g.y);
                o[4] = t1[0] + v[4] * bf_lo(g.z); o[5] = t1[1] + v[5] * bf_hi(g.z); o[6] = t1[2] + v[6] * bf_lo(g.w); o[7] = t1[3] + v[7] * bf_hi(g.w);
                *(u32x4*)(O + (size_t)row * DM + col) = pack8(o); }
        EPI_ROWS_END
    }
};
struct EpiMemKV {
    static constexpr bool PERM = true, AFTER_DRAIN = false; float* out; bf16_t* MKB;
    __device__ __forceinline__ void operator()(AccRef acc, const pg8::Unit& u, int wr, int wc, int fr, int fq) const {
        EPI_ROWS_BEGIN
#pragma unroll
            for (int bj = 0; bj < 2; ++bj) { const int col = u.pn * 256 + bj * 128 + wc * 32 + 8 * fq; EPI_V8(bj);
                float* p = out + (col < DM ? O_MKP + (size_t)row * DM + col : O_MVP + (size_t)row * DM + (col - DM));
                *(f32x4*)p = acc[ai][bj][m][0]; *(f32x4*)(p + 4) = acc[ai][bj][m][1];
                *(u32x4*)(MKB + (size_t)row * 2048 + col) = pack8(v); }
        EPI_ROWS_END
    }
};
struct EpiInGate {
    static constexpr bool PERM = true, AFTER_DRAIN = false; bf16_t* QKV; bf16_t* G; const float* bg; float* out; bf16_t* VTA; bf16_t* VTB;
    __device__ __forceinline__ void operator()(AccRef acc, const pg8::Unit& u, int wr, int wc, int fr, int fq) const {
        const int region = u.pn >> 1;
        EPI_ROWS_BEGIN
            const bool samp = row >= MP;
#pragma unroll
            for (int bj = 0; bj < 2; ++bj) { const int col = u.pn * 256 + bj * 128 + wc * 32 + 8 * fq; EPI_V8(bj);
                if (u.pn < 12) {
                    const int cc = col - region * 512; float* p = nullptr;
                    if (region != 2 && region != 5) *(u32x4*)(QKV + (size_t)row * NIN + col) = pack8(v);
                    else if (!samp) { const u32x4 w8 = pack8(v); bf16_t* vt = (region == 2 ? VTA : VTB) + ((size_t)((row >> 14) * 512 + cc) * SEQ + (row & (SEQ - 1)));
                        vt[0 * (size_t)SEQ] = (bf16_t)(w8.x & 0xffffu); vt[1 * (size_t)SEQ] = (bf16_t)(w8.x >> 16); vt[2 * (size_t)SEQ] = (bf16_t)(w8.y & 0xffffu); vt[3 * (size_t)SEQ] = (bf16_t)(w8.y >> 16);
                        vt[4 * (size_t)SEQ] = (bf16_t)(w8.z & 0xffffu); vt[5 * (size_t)SEQ] = (bf16_t)(w8.z >> 16); vt[6 * (size_t)SEQ] = (bf16_t)(w8.w & 0xffffu); vt[7 * (size_t)SEQ] = (bf16_t)(w8.w >> 16); }
                    if (region == 1 || region == 2) {
                        if (!samp) { const int n = row >> 14, t = row & (SEQ - 1); if (t >= SEQ - LA) p = out + (region == 1 ? O_AKP : O_AVP) + ((size_t)(n * LA + t - (SEQ - LA)) * 512 + cc); }
                        else { const int rs = row - MP, n = rs >> 4, t = rs & 15; p = out + (region == 1 ? O_AKS : O_AVS) + ((size_t)(n * LA + (LA - DS) + t) * 512 + cc); }
                    } else if (region == 4 || region == 5) {
                        p = samp ? out + (region == 4 ? O_BKS : O_BVS) + ((size_t)(row - MP) * 512 + cc) : out + (region == 4 ? O_BKP : O_BVP) + ((size_t)row * 512 + cc);
                    }
                    if (p) { *(f32x4*)p = acc[ai][bj][m][0]; *(f32x4*)(p + 4) = acc[ai][bj][m][1]; }
                } else {
                    const int gc = col - NIN; const f32x4 b0 = *(const f32x4*)(bg + gc), b1 = *(const f32x4*)(bg + gc + 4);
                    float o[8];
#pragma unroll
                    for (int i = 0; i < 8; ++i) { const float z = v[i] + (i < 4 ? b0[i & 3] : b1[i & 3]); o[i] = __builtin_amdgcn_rcpf(1.0f + __builtin_amdgcn_exp2f(-z * LOG2E)); }
                    *(u32x4*)(G + (size_t)row * NGATE + gc) = pack8(o);
                }
            }
        EPI_ROWS_END
    }
};

template <int K, class F> __device__ __forceinline__ void small_gemm(LAS unsigned char* lds, const bf16_t* A, const bf16_t* Bt, int ntn, bool swiglu, int t0, int G, int wave, int lane, const F& f) {
    constexpr int KS = K / 8;
    static_assert(KS % 16 == 0, "K slice");
    const int r32 = lane & 31, hi = lane >> 5;
    LAS float* P = (LAS float*)lds;
    for (int wt = t0; wt < 16 * ntn; wt += G) {
        const int tm = wt & 15, tn = wt >> 4;
        const int brow0 = swiglu ? (tn >> 2) * 256 + (tn & 3) * 32 : tn * 64, brow1 = brow0 + (swiglu ? 128 : 32);
        const int ccol = swiglu ? (tn >> 2) * 128 + (tn & 3) * 32 : tn * 64;
        const bf16_t* ap = A + (size_t)(tm * 32 + r32) * K + wave * KS + hi * 8; const bf16_t* b0 = Bt + (size_t)(brow0 + r32) * K + wave * KS + hi * 8; const bf16_t* b1 = Bt + (size_t)(brow1 + r32) * K + wave * KS + hi * 8;
        f32x16 acc0, acc1;
#pragma unroll
        for (int r = 0; r < 16; ++r) { acc0[r] = 0.f; acc1[r] = 0.f; }
#pragma unroll 8
        for (int k = 0; k < KS; k += 16) { const bf16x8 a = *(const bf16x8*)(ap + k), x0 = *(const bf16x8*)(b0 + k), x1 = *(const bf16x8*)(b1 + k);
            acc0 = __builtin_amdgcn_mfma_f32_32x32x16_bf16(x0, a, acc0, 0, 0, 0); acc1 = __builtin_amdgcn_mfma_f32_32x32x16_bf16(x1, a, acc1, 0, 0, 0); }
#pragma unroll
        for (int r = 0; r < 16; ++r) { P[(wave * 32 + r) * 64 + lane] = acc0[r]; P[(wave * 32 + 16 + r) * 64 + lane] = acc1[r]; }
        __syncthreads();
        if (wave < 4) { const int g = wave; f32x4 a = {0.f, 0.f, 0.f, 0.f}, b = {0.f, 0.f, 0.f, 0.f};
#pragma unroll
            for (int w = 0; w < 8; ++w)
#pragma unroll
                for (int i = 0; i < 4; ++i) { a[i] += P[(w * 32 + 4 * g + i) * 64 + lane]; b[i] += P[(w * 32 + 16 + 4 * g + i) * 64 + lane]; }
            f(tm * 32 + r32, ccol + 8 * g + 4 * hi, a, b); }
        __syncthreads();
    }
}
__device__ __forceinline__ u32x2 pack4(f32x4 v) { u32x2 w; w.x = cvt_pk_bf16(v.x, v.y); w.y = cvt_pk_bf16(v.z, v.w); return w; }
__device__ __forceinline__ f32x4 unpack4(u32x2 w) { return (f32x4){bf_lo(w.x), bf_hi(w.x), bf_lo(w.y), bf_hi(w.y)}; }
__device__ __forceinline__ float sigm(float z) { return __builtin_amdgcn_rcpf(1.0f + __builtin_amdgcn_exp2f(-z * LOG2E)); }
struct SSwiglu { bf16_t* O;
    __device__ __forceinline__ void operator()(int row, int col, f32x4 g, f32x4 up) const { f32x4 o; o.x = g.x * sigm(g.x) * up.x; o.y = g.y * sigm(g.y) * up.y; o.z = g.z * sigm(g.z) * up.z; o.w = g.w * sigm(g.w) * up.w;
        *(u32x2*)(O + (size_t)row * DFF + col) = pack4(o); } };
struct SBf16 { bf16_t* O; int ldc;
    __device__ __forceinline__ void operator()(int row, int col, f32x4 a, f32x4 b) const { bf16_t* p = O + (size_t)row * ldc + col; *(u32x2*)p = pack4(a); *(u32x2*)(p + 32) = pack4(b); } };
struct SBrA { const bf16_t* G; float* T;
    __device__ __forceinline__ void operator()(int row, int col, f32x4 a, f32x4 b) const { const bf16_t* g = G + (size_t)row * NGATE + col; float* t = T + (size_t)row * DM + col;
        *(f32x4*)t = a * unpack4(*(const u32x2*)g); *(f32x4*)(t + 32) = b * unpack4(*(const u32x2*)(g + 32)); } };
struct SBrB { const bf16_t* G; const float* T; bf16_t* O;
    __device__ __forceinline__ void operator()(int row, int col, f32x4 a, f32x4 b) const { const bf16_t* g = G + (size_t)row * NGATE + DM + col; const float* t = T + (size_t)row * DM + col; bf16_t* o = O + (size_t)row * DM + col;
        *(u32x2*)o = pack4(*(const f32x4*)t + a * unpack4(*(const u32x2*)g)); *(u32x2*)(o + 32) = pack4(*(const f32x4*)(t + 32) + b * unpack4(*(const u32x2*)(g + 32))); } };
struct SMemKV { float* out; bf16_t* MK;
    __device__ __forceinline__ void one(int row, int col, f32x4 v) const { *(f32x4*)(out + (col < DM ? O_MKP + (size_t)row * DM + col : O_MVP + (size_t)row * DM + (col - DM))) = v; *(u32x2*)(MK + (size_t)row * 2048 + col) = pack4(v); }
    __device__ __forceinline__ void operator()(int row, int col, f32x4 a, f32x4 b) const { one(row, col, a); one(row, col + 32, b); } };
struct SInGate { bf16_t* Q; bf16_t* G; const float* bg; float* out;
    __device__ __forceinline__ void one(int row, int col, f32x4 v) const {
        if (col < NIN) { const int region = col >> 9, cc = col & 511, n = row >> 4, t = row & 15;
            if (region != 2 && region != 5) *(u32x2*)(Q + (size_t)row * NIN + col) = pack4(v);
            if (region == 1 || region == 2) *(f32x4*)(out + (region == 1 ? O_AKS : O_AVS) + ((size_t)(n * LA + (LA - DS) + t) * 512 + cc)) = v;
            else if (region == 4 || region == 5) *(f32x4*)(out + (region == 4 ? O_BKS : O_BVS) + ((size_t)row * 512 + cc)) = v;
        } else { const int gc = col - NIN; const f32x4 b = *(const f32x4*)(bg + gc); f32x4 o; o.x = sigm(v.x + b.x); o.y = sigm(v.y + b.y); o.z = sigm(v.z + b.z); o.w = sigm(v.w + b.w);
            *(u32x2*)(G + (size_t)row * NGATE + gc) = pack4(o); } }
    __device__ __forceinline__ void operator()(int row, int col, f32x4 a, f32x4 b) const { one(row, col, a); one(row, col + 32, b); } };

__device__ __forceinline__ unsigned f2bf(float f) { unsigned u = __builtin_bit_cast(unsigned, f); return (u + 0x7fffu + ((u >> 16) & 1u)) >> 16; }
__device__ __forceinline__ unsigned pk2(float lo, float hi) { return f2bf(lo) | (f2bf(hi) << 16); }
__device__ __forceinline__ int up_row(int n) { return n < DFF ? ((n >> 7) << 8) + (n & 127) : ((((n - DFF) >> 7) << 8) + 128 + ((n - DFF) & 127)); }
template <bool UP> __device__ __forceinline__ void transpose_item(const float* W, int K, int N, bf16_t* WT, int row_off, LAS float* scr, int item, int lane) {
    const int nblk = N / 32, kb = item / nblk, nb = item % nblk, k0 = 64 * kb, n0 = 32 * nb;
#pragma unroll 8
    for (int i = 0; i < 32; ++i) { const int kk = 2 * i + (lane >> 5); scr[kk * 33 + (lane & 31)] = W[(size_t)(k0 + kk) * N + n0 + (lane & 31)]; }
    asm volatile("s_waitcnt lgkmcnt(0)" ::: "memory");
    const int c = lane & 7;
    const int r0 = UP ? up_row(n0) : row_off + n0;
#pragma unroll
    for (int j = 0; j < 4; ++j) { const int n = (lane >> 3) + 8 * j; const LAS float* s = scr + (8 * c) * 33 + n;
        u32x4 o; o.x = pk2(s[0 * 33], s[1 * 33]); o.y = pk2(s[2 * 33], s[3 * 33]); o.z = pk2(s[4 * 33], s[5 * 33]); o.w = pk2(s[6 * 33], s[7 * 33]);
        *(u32x4*)(WT + (size_t)(r0 + n) * K + k0 + 8 * c) = o; }
    asm volatile("s_waitcnt lgkmcnt(0)" ::: "memory");
}
__device__ __forceinline__ void rms_row_to_bf16(const float* xrow, const float* g, bf16_t* orow, int lane) {
    const f32x4* xr = (const f32x4*)xrow + lane; const f32x4* gr = (const f32x4*)g + lane;
    f32x4 v[4]; float s = 0.f;
#pragma unroll
    for (int j = 0; j < 4; ++j) { v[j] = xr[64 * j]; s += (v[j].x * v[j].x + v[j].y * v[j].y) + (v[j].z * v[j].z + v[j].w * v[j].w); }
    const float rstd = 1.0f / sqrtf(wave_sum(s) * (1.f / DM) + EPS);
    u32x2* o8 = (u32x2*)orow + lane;
#pragma unroll
    for (int j = 0; j < 4; ++j) { const f32x4 gg = gr[64 * j]; u32x2 w; w.x = cvt_pk_bf16(v[j].x * rstd * gg.x, v[j].y * rstd * gg.y); w.y = cvt_pk_bf16(v[j].z * rstd * gg.z, v[j].w * rstd * gg.w); o8[64 * j] = w; }
}
__device__ __forceinline__ f32x4 ld_bf4(const bf16_t* row, int lane, int j) { const u32x2 w = ((const u32x2*)row + lane)[64 * j]; return (f32x4){bf_lo(w.x), bf_hi(w.x), bf_lo(w.y), bf_hi(w.y)}; }
__device__ __forceinline__ void st_bf4(bf16_t* row, int lane, int j, f32x4 v) { u32x2 w; w.x = cvt_pk_bf16(v.x, v.y); w.y = cvt_pk_bf16(v.z, v.w); ((u32x2*)row + lane)[64 * j] = w; }
template <bool BASE_F32, bool FINAL> __device__ __forceinline__ void res_row(const void* base, const bf16_t* d, const float* gres, float coef, float* outp, bf16_t* hout, const float* gnorm, bf16_t* xn, int lane) {
    const f32x4* gr = (const f32x4*)gres + lane;
    f32x4 dv[4], hv[4]; float s = 0.f;
#pragma unroll
    for (int j = 0; j < 4; ++j) { dv[j] = ld_bf4(d, lane, j); hv[j] = BASE_F32 ? ((const f32x4*)base + lane)[64 * j] : ld_bf4((const bf16_t*)base, lane, j);
        s += (dv[j].x * dv[j].x + dv[j].y * dv[j].y) + (dv[j].z * dv[j].z + dv[j].w * dv[j].w); }
    const float rs = coef / sqrtf(wave_sum(s) * (1.f / DM) + EPS);
    float s2 = 0.f;
#pragma unroll
    for (int j = 0; j < 4; ++j) { const f32x4 gg = gr[64 * j]; hv[j] = hv[j] + dv[j] * gg * rs; s2 += (hv[j].x * hv[j].x + hv[j].y * hv[j].y) + (hv[j].z * hv[j].z + hv[j].w * hv[j].w);
        if (FINAL) ((f32x4*)outp + lane)[64 * j] = hv[j]; else st_bf4(hout, lane, j, hv[j]); }
    if (!FINAL) {
        const float rstd = 1.0f / sqrtf(wave_sum(s2) * (1.f / DM) + EPS);
        const f32x4* gn = (const f32x4*)gnorm + lane;
#pragma unroll
        for (int j = 0; j < 4; ++j) { const f32x4 gg = gn[64 * j]; st_bf4(xn, lane, j, hv[j] * gg * rstd); }
    }
}

struct AUnit {
    const bf16_t* Q; int ldq; int nq; int qpos0;
    const void* K0; const void* V0; int ld0; int nt0;
    const void* K1; const void* V1; int ld1; int n1; int ldv1;
    int kpos0, tb, te, nkeys, head;
    bf16_t* O; int ldo;
};
template <bool F32> struct Piece;
template <> struct Piece<true> { f32x4 a, b; };
template <> struct Piece<false> { u32x4 a; };
__device__ __forceinline__ void piece_load(Piece<true>& p, const void* base, size_t eoff) { const float* s = (const float*)base + eoff; p.a = *(const f32x4*)s; p.b = *(const f32x4*)(s + 4); }
__device__ __forceinline__ void piece_load(Piece<false>& p, const void* base, size_t eoff) { p.a = *(const u32x4*)((const bf16_t*)base + eoff); }
__device__ __forceinline__ u32x4 piece_bf16(const Piece<true>& p) { u32x4 w; w.x = cvt_pk_bf16(p.a[0], p.a[1]); w.y = cvt_pk_bf16(p.a[2], p.a[3]); w.z = cvt_pk_bf16(p.b[0], p.b[1]); w.w = cvt_pk_bf16(p.b[2], p.b[3]); return w; }
__device__ __forceinline__ u32x4 piece_bf16(const Piece<false>& p) { return p.a; }

template <int MODE, bool F32>
__device__ __forceinline__ void attn_unit(LAS unsigned char* lds, const AUnit& u, const float lam, const float* __restrict__ relb, const float* __restrict__ subg) {
    constexpr bool VT = (MODE != 2) && !F32;
    constexpr int DQK = (MODE == 2) ? 256 : 64, KW = (MODE == 2) ? 256 : 128, DV = (MODE == 0) ? 64 : 128, VW = (MODE == 2) ? 256 : 128;
    constexpr int KSTRB = KW * 2 + 16, VSTRB = 136, VOFFB = 64 * KSTRB, STAGE = VOFFB + VW * VSTRB;
    constexpr int NKP = KW / 64, NVP = VW / 64, NDB = DV / 32;
    constexpr float SCL = ((MODE == 2) ? 0.0625f : 0.125f) * LOG2E, THR = 8.0f;
    const int tid = threadIdx.x, lane = tid & 63, wid = __builtin_amdgcn_readfirstlane(tid >> 6), r32 = lane & 31, hi = lane >> 5;
    const int qg = wid >> 1, s = wid & 1;
    const int koff = (KW == 2 * DQK) ? s * DQK : 0, voff = (VW == 2 * DV) ? s * DV : 0;
    const bool active = (qg * 32 < u.nq);
    const int qrow = qg * 32 + r32, qrow_c = qrow < u.nq ? qrow : u.nq - 1;
    const bf16_t* qp = u.Q + (size_t)qrow_c * u.ldq + ((MODE == 2) ? 0 : s * 64) + hi * 8;
    bf16x8 qf[4];
    if (MODE != 2 && !F32) {
#pragma unroll
        for (int d0 = 0; d0 < 4; ++d0) qf[d0] = *(const bf16x8*)(qp + d0 * 16);
    }
    const int pq = u.qpos0 + qrow;
    const int cq = (u.qpos0 + qg * 32) >> 6;
    float slope2 = 0.f;
    bf16x8 kaugA = {0, 0, 0, 0, 0, 0, 0, 0}, kaugB = {0, 0, 0, 0, 0, 0, 0, 0}, qaug = {0, 0, 0, 0, 0, 0, 0, 0};
    if (MODE == 1) {
        slope2 = __builtin_amdgcn_exp2f(-2.0f * (float)(u.head + 1)) * LOG2E;
        if (!F32 && hi == 0) { kaugA[0] = (short)(__float_as_uint((float)r32) >> 16); kaugB[0] = (short)(__float_as_uint((float)(32 + r32)) >> 16);
            qaug[0] = (short)(__float_as_uint(__builtin_amdgcn_exp2f((float)(1 - 2 * u.head))) >> 16); }
    }
    const float* rb = relb + (size_t)(u.head + s) * 257;
    float m_run = -1e30f, l_run = 0.f;
    f32x16 o[NDB];
#pragma unroll
    for (int db = 0; db < NDB; ++db)
#pragma unroll
        for (int r = 0; r < 16; ++r) o[db][r] = 0.f;
    Piece<F32> kr[NKP], vr[NVP];
#define ATT_LOAD(t) do { const int t_ = (t); const bool s0_ = t_ < u.nt0; const void* kb_ = s0_ ? u.K0 : u.K1; const void* vb_ = s0_ ? u.V0 : u.V1; const int ld_ = s0_ ? u.ld0 : u.ld1; \
        const int rb_ = s0_ ? 64 * t_ : 64 * (t_ - u.nt0); const int lim_ = s0_ ? 0x7fffffff : u.n1 - 1; \
        _Pragma("unroll") for (int i_ = 0; i_ < NKP; ++i_) { const int p_ = tid + 512 * i_; int row_ = rb_ + p_ / (KW / 8); row_ = row_ < lim_ ? row_ : lim_; piece_load(kr[i_], kb_, (size_t)row_ * ld_ + (p_ % (KW / 8)) * 8); } \
        if (VT) { _Pragma("unroll") for (int i_ = 0; i_ < NVP; ++i_) { const int p_ = tid + 512 * i_; piece_load(vr[i_], u.V1, (size_t)(p_ >> 3) * u.ldv1 + 64 * t_ + (p_ & 7) * 8); } } \
        else { _Pragma("unroll") for (int i_ = 0; i_ < NVP; ++i_) { const int w_ = (tid >> 6) + 8 * i_; int row_ = rb_ + 16 * (w_ & 3) + (lane & 15); row_ = row_ < lim_ ? row_ : lim_; piece_load(vr[i_], vb_, (size_t)row_ * ld_ + (4 * (w_ >> 2) + (lane >> 4)) * 8); } } } while (0)
#define ATT_WRITE(buf) do { LAS unsigned char* b_ = (buf); \
        _Pragma("unroll") for (int i_ = 0; i_ < NKP; ++i_) { const int p_ = tid + 512 * i_; *(LAS u32x4*)(b_ + (p_ / (KW / 8)) * KSTRB + (p_ % (KW / 8)) * 16) = piece_bf16(kr[i_]); } \
        if (VT) { _Pragma("unroll") for (int i_ = 0; i_ < NVP; ++i_) { const int p_ = tid + 512 * i_; const u32x4 w4_ = piece_bf16(vr[i_]); LAS unsigned char* vp_ = b_ + VOFFB + (p_ >> 3) * VSTRB + (p_ & 7) * 16; \
                *(LAS u32x2*)vp_ = (u32x2){w4_.x, w4_.y}; *(LAS u32x2*)(vp_ + 8) = (u32x2){w4_.z, w4_.w}; } } \
        else { _Pragma("unroll") for (int i_ = 0; i_ < NVP; ++i_) { const int w_ = (tid >> 6) + 8 * i_; const int row_ = 16 * (w_ & 3) + (lane & 15), c8_ = 4 * (w_ >> 2) + (lane >> 4); const u32x4 b4_ = piece_bf16(vr[i_]); \
                LAS bf16_t* vp_ = (LAS bf16_t*)(b_ + VOFFB + (c8_ * 8) * VSTRB) + row_; \
                vp_[0 * (VSTRB / 2)] = (bf16_t)(b4_.x & 0xffffu); vp_[1 * (VSTRB / 2)] = (bf16_t)(b4_.x >> 16); vp_[2 * (VSTRB / 2)] = (bf16_t)(b4_.y & 0xffffu); vp_[3 * (VSTRB / 2)] = (bf16_t)(b4_.y >> 16); \
                vp_[4 * (VSTRB / 2)] = (bf16_t)(b4_.z & 0xffffu); vp_[5 * (VSTRB / 2)] = (bf16_t)(b4_.z >> 16); vp_[6 * (VSTRB / 2)] = (bf16_t)(b4_.w & 0xffffu); vp_[7 * (VSTRB / 2)] = (bf16_t)(b4_.w >> 16); } } } while (0)
    const int nt = u.te - u.tb;
    ATT_LOAD(u.te - 1);
    ATT_WRITE(lds);
    if (nt > 1) ATT_LOAD(u.te - 2);
    __syncthreads();
    for (int j = 0; j < nt; ++j) {
        const int t = u.te - 1 - j;
        LAS unsigned char* cur = lds + (j & 1) * STAGE;
        if (j + 1 < nt) ATT_WRITE(lds + ((j + 1) & 1) * STAGE);
        if (!F32 && j + 2 < nt) ATT_LOAD(t - 2);
        const int ck = (u.kpos0 + 64 * t) >> 6;
        bool vis = active;
        if (MODE == 0) vis = vis && (ck <= cq) && (ck >= cq - 8);
        if (MODE == 1) vis = vis && (ck <= cq);
        if (vis) {
            f32x16 sA, sB;
#pragma unroll
            for (int r = 0; r < 16; ++r) { sA[r] = 0.f; sB[r] = 0.f; }
            const bool aug = (MODE == 1) && !F32 && (ck < cq);
            if (MODE == 1 && !F32 && aug) {
                sA = __builtin_amdgcn_mfma_f32_32x32x16_bf16(kaugA, qaug, sA, 0, 0, 0);
                sB = __builtin_amdgcn_mfma_f32_32x32x16_bf16(kaugB, qaug, sB, 0, 0, 0);
            }
            if (MODE != 2) {
#pragma unroll
                for (int d0 = 0; d0 < 4; ++d0) {
                    const bf16x8 ka = *(const LAS bf16x8*)(cur + r32 * KSTRB + (koff + d0 * 16 + hi * 8) * 2);
                    const bf16x8 kb = *(const LAS bf16x8*)(cur + (32 + r32) * KSTRB + (koff + d0 * 16 + hi * 8) * 2);
                    const bf16x8 q = F32 ? *(const bf16x8*)(qp + d0 * 16) : qf[d0];
                    sA = __builtin_amdgcn_mfma_f32_32x32x16_bf16(ka, q, sA, 0, 0, 0);
                    sB = __builtin_amdgcn_mfma_f32_32x32x16_bf16(kb, q, sB, 0, 0, 0);
                }
            } else {
#pragma unroll 4
                for (int d0 = 0; d0 < 16; ++d0) {
                    const bf16x8 q = *(const bf16x8*)(qp + d0 * 16);
                    const bf16x8 ka = *(const LAS bf16x8*)(cur + r32 * KSTRB + (koff + d0 * 16 + hi * 8) * 2);
                    const bf16x8 kb = *(const LAS bf16x8*)(cur + (32 + r32) * KSTRB + (koff + d0 * 16 + hi * 8) * 2);
                    sA = __builtin_amdgcn_mfma_f32_32x32x16_bf16(ka, q, sA, 0, 0, 0);
                    sB = __builtin_amdgcn_mfma_f32_32x32x16_bf16(kb, q, sB, 0, 0, 0);
                }
            }
            float SC = SCL, off = 0.f;
            const int rel0 = pq - (u.kpos0 + 64 * t) - 4 * hi;
            if (MODE == 1) {
                if (aug) off = slope2 * (float)(pq - (u.kpos0 + 64 * t));
                else { const float bf = (float)rel0; SC = 1.0f;
#pragma unroll
                    for (int r = 0; r < 16; ++r) { const float c = (float)((r & 3) + 8 * (r >> 2));
                        sA[r] = sA[r] * SCL - slope2 * __builtin_fabsf(bf - c); sB[r] = sB[r] * SCL - slope2 * __builtin_fabsf(bf - c - 32.0f); }
                }
            } else if (MODE == 0) {
                const int wmin = (u.qpos0 + qg * 32) - (u.kpos0 + 64 * t + 63);
                if (wmin >= 128) off = -rb[256] * LOG2E;
                else { SC = 1.0f;
#pragma unroll
                    for (int r = 0; r < 16; ++r) { const int c = (r & 3) + 8 * (r >> 2);
                        int ra = rel0 - c, rbb = rel0 - c - 32; ra = ra < -128 ? -128 : (ra > 128 ? 128 : ra); rbb = rbb < -128 ? -128 : (rbb > 128 ? 128 : rbb);
                        sA[r] = sA[r] * SCL + rb[ra + 128] * LOG2E; sB[r] = sB[r] * SCL + rb[rbb + 128] * LOG2E; }
                }
            }
            if (64 * (t + 1) > u.nkeys) {
                const int k0 = 64 * t + 4 * hi;
#pragma unroll
                for (int r = 0; r < 16; ++r) { const int c = (r & 3) + 8 * (r >> 2); if (k0 + c >= u.nkeys) sA[r] = -INFINITY; if (k0 + c + 32 >= u.nkeys) sB[r] = -INFINITY; }
            }
            float mxa = __builtin_fmaxf(__builtin_fmaxf(sA[0], sA[1]), sB[0]), mxb = __builtin_fmaxf(__builtin_fmaxf(sA[2], sA[3]), sB[1]);
            mxa = __builtin_fmaxf(__builtin_fmaxf(mxa, sB[2]), sB[3]);
#pragma unroll
            for (int r = 4; r < 16; r += 4) { mxa = __builtin_fmaxf(__builtin_fmaxf(mxa, sA[r]), sA[r + 1]); mxb = __builtin_fmaxf(__builtin_fmaxf(mxb, sA[r + 2]), sA[r + 3]);
                mxa = __builtin_fmaxf(__builtin_fmaxf(mxa, sB[r]), sB[r + 1]); mxb = __builtin_fmaxf(__builtin_fmaxf(mxb, sB[r + 2]), sB[r + 3]); }
            float mx = __builtin_fmaxf(mxa, mxb);
            mx = __builtin_fmaxf(mx, __shfl_xor(mx, 32));
            const float smax = mx * SC - off;
            if (__any(smax > m_run + THR)) {
                const float m_new = __builtin_fmaxf(m_run, smax);
                const float alpha = __builtin_amdgcn_exp2f(m_run - m_new);
                m_run = m_new; l_run *= alpha;
#pragma unroll
                for (int db = 0; db < NDB; ++db)
#pragma unroll
                    for (int r = 0; r < 16; ++r) o[db][r] *= alpha;
            }
            const float cs = -(off + m_run);
            float rs0 = 0.f, rs1 = 0.f;
#pragma unroll
            for (int r = 0; r < 16; ++r) { sA[r] = __builtin_amdgcn_exp2f(__builtin_fmaf(sA[r], SC, cs)); sB[r] = __builtin_amdgcn_exp2f(__builtin_fmaf(sB[r], SC, cs)); rs0 += sA[r]; rs1 += sB[r]; }
            l_run += rs0 + rs1;
            u32x4 pa0, pa1, pb0, pb1;
            pa0.x = cvt_pk_bf16(sA[0], sA[1]); pa0.y = cvt_pk_bf16(sA[2], sA[3]); pa0.z = cvt_pk_bf16(sA[4], sA[5]); pa0.w = cvt_pk_bf16(sA[6], sA[7]);
            pa1.x = cvt_pk_bf16(sA[8], sA[9]); pa1.y = cvt_pk_bf16(sA[10], sA[11]); pa1.z = cvt_pk_bf16(sA[12], sA[13]); pa1.w = cvt_pk_bf16(sA[14], sA[15]);
            pb0.x = cvt_pk_bf16(sB[0], sB[1]); pb0.y = cvt_pk_bf16(sB[2], sB[3]); pb0.z = cvt_pk_bf16(sB[4], sB[5]); pb0.w = cvt_pk_bf16(sB[6], sB[7]);
            pb1.x = cvt_pk_bf16(sB[8], sB[9]); pb1.y = cvt_pk_bf16(sB[10], sB[11]); pb1.z = cvt_pk_bf16(sB[12], sB[13]); pb1.w = cvt_pk_bf16(sB[14], sB[15]);
#pragma unroll
            for (int db = 0; db < NDB; ++db) {
                const LAS unsigned char* vrow = cur + VOFFB + (voff + db * 32 + r32) * VSTRB + hi * 8;
#define ATT_VF(base) ({ const s16x4 lo_ = *(const LAS s16x4*)(vrow + (base) * 2), hi_ = *(const LAS s16x4*)(vrow + ((base) + 8) * 2); (bf16x8){lo_[0], lo_[1], lo_[2], lo_[3], hi_[0], hi_[1], hi_[2], hi_[3]}; })
                o[db] = __builtin_amdgcn_mfma_f32_32x32x16_bf16(ATT_VF(0), __builtin_bit_cast(bf16x8, pa0), o[db], 0, 0, 0);
                o[db] = __builtin_amdgcn_mfma_f32_32x32x16_bf16(ATT_VF(16), __builtin_bit_cast(bf16x8, pa1), o[db], 0, 0, 0);
                o[db] = __builtin_amdgcn_mfma_f32_32x32x16_bf16(ATT_VF(32), __builtin_bit_cast(bf16x8, pb0), o[db], 0, 0, 0);
                o[db] = __builtin_amdgcn_mfma_f32_32x32x16_bf16(ATT_VF(48), __builtin_bit_cast(bf16x8, pb1), o[db], 0, 0, 0);
#undef ATT_VF
                if (F32) __builtin_amdgcn_sched_barrier(0);
            }
        }
        if (F32 && j + 2 < nt) ATT_LOAD(t - 2);
        __syncthreads();
    }
#undef ATT_LOAD
#undef ATT_WRITE
    const float l_tot = l_run + __shfl_xor(l_run, 32);
    const float linv = 1.0f / l_tot;
    if (MODE != 1) {
        if (active && qrow < u.nq) {
            bf16_t* op = u.O + (size_t)qrow * u.ldo + ((MODE == 0) ? s * 64 : s * 128) + 4 * hi;
#pragma unroll
            for (int db = 0; db < NDB; ++db)
#pragma unroll
                for (int g = 0; g < 4; ++g) { u32x2 w; w.x = cvt_pk_bf16(o[db][4 * g] * linv, o[db][4 * g + 1] * linv); w.y = cvt_pk_bf16(o[db][4 * g + 2] * linv, o[db][4 * g + 3] * linv);
                    *(u32x2*)(op + db * 32 + 8 * g) = w; }
        }
    } else {
        LAS float* X = (LAS float*)lds + (size_t)qg * 64 * 64 + lane;
        if (s == 1 && active) {
#pragma unroll
            for (int db = 0; db < NDB; ++db)
#pragma unroll
                for (int r = 0; r < 16; ++r) X[(db * 16 + r) * 64] = o[db][r] * linv;
        }
        __syncthreads();
        if (s == 0 && active) {
            float ss = 0.f;
#pragma unroll
            for (int db = 0; db < NDB; ++db)
#pragma unroll
                for (int r = 0; r < 16; ++r) { const float v = o[db][r] * linv - lam * X[(db * 16 + r) * 64]; o[db][r] = v; ss += v * v; }
            ss += __shfl_xor(ss, 32);
            const float rstd = 0.8f / sqrtf(ss * (1.0f / 128.0f) + EPS);
            if (qrow < u.nq) {
                bf16_t* op = u.O + (size_t)qrow * u.ldo + 4 * hi;
#pragma unroll
                for (int db = 0; db < NDB; ++db)
#pragma unroll
                    for (int g = 0; g < 4; ++g) { const f32x4 sg = *(const f32x4*)(subg + db * 32 + 8 * g + 4 * hi);
                        u32x2 w; w.x = cvt_pk_bf16(o[db][4 * g] * rstd * sg[0], o[db][4 * g + 1] * rstd * sg[1]); w.y = cvt_pk_bf16(o[db][4 * g + 2] * rstd * sg[2], o[db][4 * g + 3] * rstd * sg[3]);
                        *(u32x2*)(op + db * 32 + 8 * g) = w; }
            }
        }
    }
}

__global__ void __launch_bounds__(512, 2) fwd_kernel(Args args) {
    extern __shared__ __attribute__((aligned(16))) unsigned char lds_raw[];
    LAS unsigned char* lds = (LAS unsigned char*)lds_raw;
    cg::grid_group grid = cg::this_grid();
    const int tid = threadIdx.x, lane = tid & 63, wave = __builtin_amdgcn_readfirstlane(tid >> 6);
    const int G = gridDim.x, bx = blockIdx.x;
    const int gw = bx * 8 + wave, NGW = G * 8;
    const int sw0 = wave * G + bx;
    unsigned char* ws = args.ws; float* out = args.out;
    unsigned* ctl = (unsigned*)(ws + WS_CTL);
#define x_p (args.in[0])
#define x_s (args.in[1])
#define cak (args.in[2])
#define cav (args.in[3])
#define cbk (args.in[4])
#define cbv (args.in[5])
#define cmk (args.in[6])
#define cmv (args.in[7])
#define memp (args.in[8])
#define b_gate (args.in[11])
#define rel_bias (args.in[12])
#define lam_qk (args.in[13])
#define subln (args.in[14])
#define ng (args.in[21])
#define W_UP1 ((bf16_t*)(ws + WS_UP1))
#define W_DN1 ((bf16_t*)(ws + WS_DN1))
#define W_ING ((bf16_t*)(ws + WS_ING))
#define W_BRA ((bf16_t*)(ws + WS_BRA))
#define W_BRB ((bf16_t*)(ws + WS_BRB))
#define W_OUT ((bf16_t*)(ws + WS_OUT))
#define W_MQ ((bf16_t*)(ws + WS_MQ))
#define W_MKV ((bf16_t*)(ws + WS_MKV))
#define W_MO ((bf16_t*)(ws + WS_MO))
#define W_UP2 ((bf16_t*)(ws + WS_UP2))
#define W_DN2 ((bf16_t*)(ws + WS_DN2))
#define MKB ((bf16_t*)(ws + WS_MKB))
#define MEMN ((bf16_t*)(ws + WS_MEMN))
#define XN ((bf16_t*)(ws + WS_XN))
#define ACT ((bf16_t*)(ws + WS_ACT))
#define DF ((float*)(ws + WS_DF))
#define H ((bf16_t*)(ws + WS_H))
#define DFB ((bf16_t*)(ws + WS_DF))
#define QKV ((bf16_t*)(ws + WS_QKV))
#define GATES ((bf16_t*)(ws + WS_GATES))
#define YA ((bf16_t*)(ws + WS_YA))
#define YB ((bf16_t*)(ws + WS_YB))
#define MKS ((bf16_t*)(ws + WS_MKS))
#define QM QKV
#define OM ACT
#define VTA ACT
#define VTB (ACT + (size_t)NB * 512 * SEQ)
    const int lo = args.ph_lo, hi_ph = args.ph_hi;
#ifndef PH_MASK
#define PH_MASK 0xffffffffu
#endif
#define IN(k) ((((PH_MASK) >> (k)) & 1u) && lo <= (k) && (k) < hi_ph)
#define SEAM(k) do { if (IN(k) && IN((k) + 1)) grid.sync(); } while (0)
#define GEMM_PHASE(EPI, e, Aptr, Bptr, Mrows, Ncols, Kdim, cidx) do { pg8::Gemm g_{(const pg8::bf16_t*)(Aptr), (const pg8::bf16_t*)(Bptr), (Mrows), (Ncols), (Kdim)}; pg8::StaticOrder S_; S_.init((Mrows), (Ncols), G, (cidx)); \
        pg8::gemm_phase<EPI, pg8::StaticOrder, true, true>(lds, g_, S_, e); } while (0)

    if (IN(0)) {
        if (bx == 0 && tid < 64) ctl[tid] = 0u;
        LAS float* scr = (LAS float*)(lds + wave * 16384);
        constexpr int I_UP = 16 * (NUP / 32), I_DN = (DFF / 64) * 32, I_IN = 16 * (NIN / 32), I_GT = 16 * (NGATE / 32), I_BR = 8 * 32, I_SQ = 16 * 32, I_MKV = 16 * 64;
        constexpr int NITEMS = 2 * I_UP + 2 * I_DN + I_IN + I_GT + 2 * I_BR + 3 * I_SQ + I_MKV;
        for (int it = gw; it < NITEMS; it += NGW) {
            int r = it;
            if (r < I_UP) { transpose_item<true>(args.in[22], DM, NUP, W_UP1, 0, scr, r, lane); continue; } r -= I_UP;
            if (r < I_UP) { transpose_item<true>(args.in[24], DM, NUP, W_UP2, 0, scr, r, lane); continue; } r -= I_UP;
            if (r < I_DN) { transpose_item<false>(args.in[23], DFF, DM, W_DN1, 0, scr, r, lane); continue; } r -= I_DN;
            if (r < I_DN) { transpose_item<false>(args.in[25], DFF, DM, W_DN2, 0, scr, r, lane); continue; } r -= I_DN;
            if (r < I_IN) { transpose_item<false>(args.in[9], DM, NIN, W_ING, 0, scr, r, lane); continue; } r -= I_IN;
            if (r < I_GT) { transpose_item<false>(args.in[10], DM, NGATE, W_ING, NIN, scr, r, lane); continue; } r -= I_GT;
            if (r < I_BR) { transpose_item<false>(args.in[15], 512, DM, W_BRA, 0, scr, r, lane); continue; } r -= I_BR;
            if (r < I_BR) { transpose_item<false>(args.in[16], 512, DM, W_BRB, 0, scr, r, lane); continue; } r -= I_BR;
            if (r < I_SQ) { transpose_item<false>(args.in[17], DM, DM, W_OUT, 0, scr, r, lane); continue; } r -= I_SQ;
            if (r < I_SQ) { transpose_item<false>(args.in[18], DM, DM, W_MQ, 0, scr, r, lane); continue; } r -= I_SQ;
            if (r < I_SQ) { transpose_item<false>(args.in[20], DM, DM, W_MO, 0, scr, r, lane); continue; } r -= I_SQ;
            transpose_item<false>(args.in[19], DM, 2 * DM, W_MKV, 0, scr, r, lane);
        }
        for (int m = gw; m < MT + NB * MEMT; m += NGW) {
            if (m < MP) rms_row_to_bf16(x_p + (size_t)m * DM, ng, XN + (size_t)m * DM, lane);
            else if (m < MT) rms_row_to_bf16(x_s + (size_t)(m - MP) * DM, ng, XN + (size_t)m * DM, lane);
            else rms_row_to_bf16(memp + (size_t)(m - MT) * DM, ng + 6 * DM, MEMN + (size_t)(m - MT) * DM, lane);
        }
        for (int r = gw; r < 2 * DB * MEMT; r += NGW) {
            const int which = r / (DB * MEMT), rr = r % (DB * MEMT);
            const f32x4* src = (const f32x4*)((which ? cmv : cmk) + (size_t)rr * DM) + lane; u32x2* dst = (u32x2*)(MKS + (size_t)rr * 2048 + which * DM) + lane;
#pragma unroll
            for (int j = 0; j < 4; ++j) { const f32x4 v = src[64 * j]; u32x2 w; w.x = cvt_pk_bf16(v.x, v.y); w.y = cvt_pk_bf16(v.z, v.w); dst[64 * j] = w; }
        }
        for (int r = gw; r < 2 * DB * (LA - DS); r += NGW) {
            const int which = r / (DB * (LA - DS)), rr = r % (DB * (LA - DS)), n = rr / (LA - DS), j = rr % (LA - DS);
            const f32x4* src = (const f32x4*)((which ? cav : cak) + ((size_t)n * LA + j + DS) * 512) + lane;
            f32x4* dst = (f32x4*)(out + (which ? O_AVS : O_AKS) + ((size_t)n * LA + j) * 512) + lane;
            dst[0] = src[0]; dst[64] = src[64];
        }
    }
    SEAM(0);
    if (IN(1)) {
        { SSwiglu f{ACT + (size_t)MP * DFF}; small_gemm<DM>(lds, XN + (size_t)MP * DM, W_UP1, NUP / 64, true, bx, G, wave, lane, f); }
        { SMemKV f{out, MKB}; small_gemm<DM>(lds, MEMN, W_MKV, 2 * DM / 64, false, (bx + G / 2) % G, G, wave, lane, f);   }
        { EpiSwiglu e{ACT}; GEMM_PHASE(EpiSwiglu, e, XN, W_UP1, MP, NUP, DM, bx); }
    }
    SEAM(1);
    if (IN(2)) { { SBf16 f{DFB + (size_t)MP * DM, DM}; small_gemm<DFF>(lds, ACT + (size_t)MP * DFF, W_DN1, DM / 64, false, bx, G, wave, lane, f); }
        EpiBf16 e{DFB, DM}; GEMM_PHASE(EpiBf16, e, ACT, W_DN1, MP, DM, DFF, bx); }
    SEAM(2);
    if (IN(3)) {
        for (int m = gw; m < MT; m += NGW) res_row<true, false>(m < MP ? x_p + (size_t)m * DM : x_s + (size_t)(m - MP) * DM, DFB + (size_t)m * DM, ng + 1 * DM, 0.5f, nullptr, H + (size_t)m * DM, ng + 2 * DM, XN + (size_t)m * DM, lane);
    }
    SEAM(3);
    if (IN(4)) { { SInGate f{QKV + (size_t)MP * NIN, GATES + (size_t)MP * NGATE, b_gate, out}; small_gemm<DM>(lds, XN + (size_t)MP * DM, W_ING, NING / 64, false, bx, G, wave, lane, f); }
        EpiInGate e{QKV, GATES, b_gate, out, VTA, VTB}; GEMM_PHASE(EpiInGate, e, XN, W_ING, MP, NING, DM, bx); }
    SEAM(4);
    if (IN(5)) {
        float lam;
        { const float a = lam_qk[lane] * lam_qk[64 + lane], b = lam_qk[128 + lane] * lam_qk[192 + lane]; lam = expf(wave_sum(a)) - expf(wave_sum(b)) + 0.2f; }
        constexpr int N_SD = DB * 4, N_SB = DB * 4, N_PD = NB * 4 * 128, N_PB = NB * 4 * 128;
        volatile LAS unsigned* qw = (volatile LAS unsigned*)(lds + LDS_QW);
#ifndef REP5
#define REP5 1
#endif
        for (int rep = 0; rep < REP5; ++rep) {
        for (;;) {
            __syncthreads();
            if (tid == 0) qw[0] = atomicAdd(&ctl[4 + 2 * rep], 1u);
            __syncthreads();
            const int idx = __builtin_amdgcn_readfirstlane((int)qw[0]);
            if (idx >= N_SD + N_SB) break;
            AUnit u;
            if (idx < N_SD) {
                const int n = idx >> 2, h = idx & 3; const size_t row0 = MP + (size_t)n * DS;
                u.Q = QKV + row0 * NIN + 1536 + h * 128; u.ldq = NIN; u.nq = DS; u.qpos0 = PAST;
                u.K0 = cbk + (size_t)n * PAST * 512 + h * 128; u.V0 = cbv + (size_t)n * PAST * 512 + h * 128; u.ld0 = 512; u.nt0 = PAST / 64;
                u.K1 = out + O_BKS + (size_t)n * DS * 512 + h * 128; u.V1 = out + O_BVS + (size_t)n * DS * 512 + h * 128; u.ld1 = 512; u.ldv1 = 0; u.n1 = DS;
                u.kpos0 = 0; u.tb = 0; u.te = PAST / 64 + 1; u.nkeys = PAST + DS; u.head = h; u.O = YB + row0 * 512 + h * 128; u.ldo = 512;
                attn_unit<1, true>(lds, u, lam, rel_bias, subln);
            } else {
                const int j = idx - N_SD, n = j >> 2, hp = j & 3; const size_t row0 = MP + (size_t)n * DS;
                u.Q = QKV + row0 * NIN + hp * 128; u.ldq = NIN; u.nq = DS; u.qpos0 = PAST;
                u.K0 = cak + (size_t)n * LA * 512 + hp * 128; u.V0 = cav + (size_t)n * LA * 512 + hp * 128; u.ld0 = 512; u.nt0 = LA / 64;
                u.K1 = out + O_AKS + ((size_t)n * LA + (LA - DS)) * 512 + hp * 128; u.V1 = out + O_AVS + ((size_t)n * LA + (LA - DS)) * 512 + hp * 128; u.ld1 = 512; u.ldv1 = 0; u.n1 = DS;
                u.kpos0 = PAST - LA; u.tb = 1; u.te = LA / 64 + 1; u.nkeys = LA + DS; u.head = 2 * hp; u.O = YA + row0 * 512 + hp * 128; u.ldo = 512;
                attn_unit<0, true>(lds, u, lam, rel_bias, subln);
            }
        }
        for (;;) {
            __syncthreads();
            if (tid == 0) qw[0] = atomicAdd(&ctl[5 + 2 * rep], 1u);
            __syncthreads();
            const int idx = __builtin_amdgcn_readfirstlane((int)qw[0]);
            if (idx >= N_PD + N_PB) break;
            AUnit u;
            if (idx < N_PD) {
                const int j = idx, qb = 127 - (j >> 3), n = (j >> 2) & 1, h = j & 3; const size_t row0 = (size_t)n * SEQ + 128 * qb;
                u.Q = QKV + row0 * NIN + 1536 + h * 128; u.ldq = NIN; u.nq = 128; u.qpos0 = 128 * qb;
                u.K0 = nullptr; u.V0 = nullptr; u.ld0 = 0; u.nt0 = 0;
                u.K1 = QKV + (size_t)n * SEQ * NIN + 2048 + h * 128; u.V1 = VTB + ((size_t)n * 512 + h * 128) * SEQ; u.ld1 = NIN; u.ldv1 = SEQ; u.n1 = 0x7fffffff;
                u.kpos0 = 0; u.tb = 0; u.te = 2 * qb + 2; u.nkeys = 0x7fffffff; u.head = h; u.O = YB + row0 * 512 + h * 128; u.ldo = 512;
                attn_unit<1, false>(lds, u, lam, rel_bias, subln);
            } else {
                const int j = idx - N_PD, qb = 127 - (j >> 3), n = (j >> 2) & 1, hp = j & 3; const size_t row0 = (size_t)n * SEQ + 128 * qb;
                u.Q = QKV + row0 * NIN + hp * 128; u.ldq = NIN; u.nq = 128; u.qpos0 = 128 * qb;
                u.K0 = nullptr; u.V0 = nullptr; u.ld0 = 0; u.nt0 = 0;
                u.K1 = QKV + (size_t)n * SEQ * NIN + 512 + hp * 128; u.V1 = VTA + ((size_t)n * 512 + hp * 128) * SEQ; u.ld1 = NIN; u.ldv1 = SEQ; u.n1 = 0x7fffffff;
                u.kpos0 = 0; u.tb = (2 * qb - 8 > 0) ? 2 * qb - 8 : 0; u.te = 2 * qb + 2; u.nkeys = 0x7fffffff; u.head = 2 * hp; u.O = YA + row0 * 512 + hp * 128; u.ldo = 512;
                attn_unit<0, false>(lds, u, lam, rel_bias, subln);
            }
        }
        }
    }
    SEAM(5);
    if (IN(6)) { { SBrA f{GATES + (size_t)MP * NGATE, DF + (size_t)MP * DM}; small_gemm<512>(lds, YA + (size_t)MP * 512, W_BRA, DM / 64, false, bx, G, wave, lane, f); }
        EpiBrA e{GATES, DF}; GEMM_PHASE(EpiBrA, e, YA, W_BRA, MP, DM, 512, bx); }
    SEAM(6);
    if (IN(7)) { { SBrB f{GATES + (size_t)MP * NGATE, DF + (size_t)MP * DM, XN + (size_t)MP * DM}; small_gemm<512>(lds, YB + (size_t)MP * 512, W_BRB, DM / 64, false, bx, G, wave, lane, f); }
        EpiBrB e{GATES, DF, XN}; GEMM_PHASE(EpiBrB, e, YB, W_BRB, MP, DM, 512, bx); }
    SEAM(7);
    if (IN(8)) { { SBf16 f{DFB + (size_t)MP * DM, DM}; small_gemm<DM>(lds, XN + (size_t)MP * DM, W_OUT, DM / 64, false, bx, G, wave, lane, f); }
        EpiBf16 e{DFB, DM}; GEMM_PHASE(EpiBf16, e, XN, W_OUT, MP, DM, DM, bx); }
    SEAM(8);
    if (IN(9)) { for (int m = gw; m < MT; m += NGW) res_row<false, false>(H + (size_t)m * DM, DFB + (size_t)m * DM, ng + 3 * DM, 1.0f, nullptr, H + (size_t)m * DM, ng + 4 * DM, XN + (size_t)m * DM, lane); }
    SEAM(9);
    if (IN(10)) { { SBf16 f{QM + (size_t)MP * DM, DM}; small_gemm<DM>(lds, XN + (size_t)MP * DM, W_MQ, DM / 64, false, bx, G, wave, lane, f); }
        EpiBf16 e{QM, DM}; GEMM_PHASE(EpiBf16, e, XN, W_MQ, MP, DM, DM, bx); }
    SEAM(10);
    if (IN(11)) {
        constexpr int N_S = DB * 4, N_P = NB * 4 * 128, N_ALL = N_S + N_P;
        volatile LAS unsigned* qw = (volatile LAS unsigned*)(lds + LDS_QW);
        for (;;) {
            __syncthreads();
            if (tid == 0) qw[0] = atomicAdd(&ctl[1], 1u);
            __syncthreads();
            const int idx = __builtin_amdgcn_readfirstlane((int)qw[0]);
            if (idx >= N_ALL) break;
            AUnit u; u.ldv1 = 0; u.qpos0 = 0; u.kpos0 = 0; u.tb = 0; u.te = MEMT / 64; u.nkeys = 0x7fffffff; u.ldq = DM; u.ldo = DM;
            if (idx < N_S) {
                const int n = idx >> 2, h = idx & 3; const size_t row0 = MP + (size_t)n * DS;
                u.Q = QM + row0 * DM + h * 256; u.nq = DS; u.head = h;
                u.K0 = nullptr; u.V0 = nullptr; u.ld0 = 0; u.nt0 = 0;
                u.K1 = MKS + (size_t)n * MEMT * 2048 + h * 256; u.V1 = MKS + (size_t)n * MEMT * 2048 + DM + h * 256; u.ld1 = 2048; u.n1 = 0x7fffffff; u.O = OM + row0 * DM + h * 256;
                attn_unit<2, false>(lds, u, 0.f, rel_bias, subln);
            } else {
                const int j = idx - N_S, qb = j >> 3, n = (j >> 2) & 1, h = j & 3; const size_t row0 = (size_t)n * SEQ + 128 * qb;
                u.Q = QM + row0 * DM + h * 256; u.nq = 128; u.head = h;
                u.K0 = nullptr; u.V0 = nullptr; u.ld0 = 0; u.nt0 = 0;
                u.K1 = MKB + (size_t)n * MEMT * 2048 + h * 256; u.V1 = MKB + (size_t)n * MEMT * 2048 + DM + h * 256; u.ld1 = 2048; u.n1 = 0x7fffffff; u.O = OM + row0 * DM + h * 256;
                attn_unit<2, false>(lds, u, 0.f, rel_bias, subln);
            }
        }
    }
    SEAM(11);
    if (IN(12)) { { SBf16 f{DFB + (size_t)MP * DM, DM}; small_gemm<DM>(lds, OM + (size_t)MP * DM, W_MO, DM / 64, false, bx, G, wave, lane, f); }
        EpiBf16 e{DFB, DM}; GEMM_PHASE(EpiBf16, e, OM, W_MO, MP, DM, DM, bx); }
    SEAM(12);
    if (IN(13)) { for (int m = gw; m < MT; m += NGW) res_row<false, false>(H + (size_t)m * DM, DFB + (size_t)m * DM, ng + 5 * DM, 1.0f, nullptr, H + (size_t)m * DM, ng + 7 * DM, XN + (size_t)m * DM, lane); }
    SEAM(13);
    if (IN(14)) { { SSwiglu f{ACT + (size_t)MP * DFF}; small_gemm<DM>(lds, XN + (size_t)MP * DM, W_UP2, NUP / 64, true, bx, G, wave, lane, f); }
        EpiSwiglu e{ACT}; GEMM_PHASE(EpiSwiglu, e, XN, W_UP2, MP, NUP, DM, bx); }
    SEAM(14);
    if (IN(15)) { { SBf16 f{DFB + (size_t)MP * DM, DM}; small_gemm<DFF>(lds, ACT + (size_t)MP * DFF, W_DN2, DM / 64, false, bx, G, wave, lane, f); }
        EpiBf16 e{DFB, DM}; GEMM_PHASE(EpiBf16, e, ACT, W_DN2, MP, DM, DFF, bx); }
    SEAM(15);
    if (IN(16)) { for (int m = gw; m < MT; m += NGW) res_row<false, true>(H + (size_t)m * DM, DFB + (size_t)m * DM, ng + 8 * DM, 0.5f, out + O_YP + (size_t)m * DM, nullptr, nullptr, nullptr, lane); }
#undef IN
#undef SEAM
#undef GEMM_PHASE
}
constexpr int N_PHASES = 17;

extern "C" void kernel_launch(void* const* d_in, const int* in_sizes, int n_in, void* d_out, int out_size, void* d_ws, size_t ws_size, hipStream_t stream) {
    static int grid = 0;
    if (grid == 0) {
        if (n_in != 26 || (size_t)out_size != O_END || ws_size < WS_END) { fprintf(stderr, "kernel_launch: unexpected shapes: n_in %d out %d (want %zu) ws %zu (want %zu)\n", n_in, out_size, (size_t)O_END, ws_size, (size_t)WS_END); grid = -1; return; }
        int dev = 0, cus = 0, per_cu = 0;
        hipGetDevice(&dev); hipDeviceGetAttribute(&cus, hipDeviceAttributeMultiprocessorCount, dev);
        if (hipFuncSetAttribute((const void*)fwd_kernel, hipFuncAttributeMaxDynamicSharedMemorySize, LDS_BYTES) != hipSuccess) { fprintf(stderr, "kernel_launch: hipFuncSetAttribute failed\n"); grid = -1; return; }
        if (hipOccupancyMaxActiveBlocksPerMultiprocessor(&per_cu, (const void*)fwd_kernel, 512, LDS_BYTES) != hipSuccess || per_cu < 1) { fprintf(stderr, "kernel_launch: occupancy query says %d\n", per_cu); per_cu = 1; }
        (void)hipGetLastError();
        grid = cus * 1;
        if (grid <= 0) grid = 256;
    }
    if (grid < 0) return;
    (void)hipMemsetAsync((char*)d_ws + WS_CTL, 0, 4096, stream);
    Args a{};
    for (int i = 0; i < 26; ++i) a.in[i] = (const float*)d_in[i];
    a.out = (float*)d_out; a.ws = (unsigned char*)d_ws;
#if MK_MULTI
    for (int p = 0; p < N_PHASES; ++p) { a.ph_lo = p; a.ph_hi = p + 1; hipLaunchKernelGGL(fwd_kernel, dim3(grid), dim3(512), LDS_BYTES, stream, a); }
#else
    a.ph_lo = 0; a.ph_hi = N_PHASES;
    void* kargs[] = {&a};
    hipError_t e = hipLaunchCooperativeKernel((const void*)fwd_kernel, dim3(grid), dim3(512), kargs, LDS_BYTES, stream);
    if (e != hipSuccess) fprintf(stderr, "kernel_launch: cooperative launch failed: %s (grid %d)\n", hipGetErrorString(e), grid);
#endif
}
```

```cpp
#include <hip/hip_runtime.h>
#include <hip/hip_cooperative_groups.h>
#include <cstdio>
#include <cstdint>
namespace cg = cooperative_groups;
#ifndef MK_MULTI
#define MK_MULTI 0
#endif
namespace pg8 {
#define PG8_LAS __attribute__((address_space(3)))
typedef unsigned short bf16_t;
typedef short bf16x8 __attribute__((ext_vector_type(8)));
typedef float f32x4 __attribute__((ext_vector_type(4)));
typedef unsigned u32x4 __attribute__((ext_vector_type(4)));
constexpr int BM = 256, BK = 64, HALF = 128, HTB = HALF * BK * 2  , STAGE_BYTES = 8 * HTB, NXCD = 8, WGM = 8;

__host__ __device__ __forceinline__ int lds_byte(int r, int c) { const int st = (r >> 4) * 2 + (c >> 5), rr = r & 15, cc = c & 31, ob = rr * 64 + cc * 2; return st * 1024 + (ob ^ (((ob >> 9) & 1) << 5)); }
__host__ __device__ __forceinline__ void stage_rc(int b, int& R, int& C) { const int st = b / 1024, sb = b % 1024, swz = sb ^ (((sb >> 9) & 1) << 5); R = (st >> 1) * 16 + swz / 64; C = (st & 1) * 32 + (swz % 64) / 2; }
__host__ __device__ __forceinline__ int perm32(int rho) { const int n = rho >> 4, i = rho & 15; return 8 * (i >> 2) + 4 * n + (i & 3); }

struct Unit { int pm, pn; };
struct Gemm { const bf16_t* A; const bf16_t* Bt; int M, N, K; };

struct StaticOrder {
    int nM, nN, nwg, G, c;
    __host__ __device__ void init(int M, int N, int G_, int c_) { nM = M / BM; nN = N / BM; nwg = nM * nN; G = G_; c = c_; }
    __host__ __device__ bool next(int i, Unit& u) const {
        const long L = (long)i * G + c; if (L >= nwg) return false;
        int wgid = (int)L; { const int q = nwg / NXCD, r = nwg % NXCD, xcd = wgid % NXCD, off = wgid / NXCD; wgid = (xcd < r ? xcd * (q + 1) : r * (q + 1) + (xcd - r) * q) + off; }
        const int nig = WGM * nN, gid = wgid / nig, fm = gid * WGM, gsz = (nM - fm) < WGM ? (nM - fm) : WGM;
        u.pm = fm + ((wgid % nig) % gsz); u.pn = (wgid % nig) / gsz; return true;
    }
    __device__ __forceinline__ void a_ready(const Unit&) const {}
    __device__ __forceinline__ void done(const Unit&) const {}
};

__device__ __forceinline__ unsigned cvt_pk_bf16(float lo, float hi) { unsigned r; asm volatile("v_cvt_pk_bf16_f32 %0, %1, %2" : "=v"(r) : "v"(lo), "v"(hi)); return r; }
typedef float f32x2 __attribute__((ext_vector_type(2)));
template <class Epi, class Sched, bool ALIGN_EPI = false, bool SP2 = false>
__device__ __forceinline__ void gemm_phase(PG8_LAS unsigned char* lds, const Gemm g, const Sched& S, const Epi& E) {
    const int tid = threadIdx.x, wid = __builtin_amdgcn_readfirstlane(tid >> 6), lane = tid & 63, wr = wid >> 2, wc = wid & 3, fr = lane & 15, fq = lane >> 4;
    const int K = g.K, nt = K / BK;
    unsigned voffA[2], voffB[2];
#pragma unroll
    for (int i = 0; i < 2; ++i) { int R, C; stage_rc(tid * 16 + i * 8192, R, C); const int Rb = Epi::PERM ? ((R & ~31) + perm32(R & 31)) : R;
        voffA[i] = (unsigned)(R * K + C) * 2u; voffB[i] = (unsigned)(Rb * K + C) * 2u; }
    const size_t kstep = (size_t)(BK * 2);
    const size_t hstep = (size_t)HALF * K * 2;
    const size_t tstep = 2 * hstep;
    const unsigned ldsw = (unsigned)wid * 1024u;
    const int aoff = lds_byte(wr * 64 + fr, fq * 8), boff = lds_byte(wc * 32 + fr, fq * 8);
#define PG8_SA(b, h) (((b) * 2 + (h)) * HTB)
#define PG8_SB(b, h) ((4 + (b) * 2 + (h)) * HTB)
#define PG8_STAGE(bufoff, gbase, voff) do { _Pragma("unroll") for (int _i = 0; _i < 2; ++_i) \
        __builtin_amdgcn_global_load_lds((const unsigned*)((const char*)(gbase) + (voff)[_i]), (PG8_LAS unsigned*)(lds + (bufoff) + ldsw + _i * 8192), 16, 0, 0); } while (0)
#define PG8_LDA(dst, b, h) do { _Pragma("unroll") for (int m = 0; m < 4; ++m) _Pragma("unroll") for (int k = 0; k < 2; ++k) dst[m][k] = *(const PG8_LAS bf16x8*)(lds + PG8_SA(b, h) + aoff + m * 2048 + k * 1024); } while (0)
#define PG8_LDB(dst, b, h) do { _Pragma("unroll") for (int n = 0; n < 2; ++n) _Pragma("unroll") for (int k = 0; k < 2; ++k) dst[n][k] = *(const PG8_LAS bf16x8*)(lds + PG8_SB(b, h) + boff + n * 2048 + k * 1024); } while (0)
#define PG8_MMA(ai, bj, At, Bt) do { __builtin_amdgcn_s_setprio(1); _Pragma("unroll") for (int m = 0; m < 4; ++m) _Pragma("unroll") for (int n = 0; n < 2; ++n) _Pragma("unroll") for (int k = 0; k < 2; ++k) \
        acc[ai][bj][m][n] = __builtin_amdgcn_mfma_f32_16x16x32_bf16(Bt[n][k], At[m][k], acc[ai][bj][m][n], 0, 0, 0); __builtin_amdgcn_s_setprio(0); } while (0)
#define PG8_WAIT_V(n) asm volatile("s_waitcnt vmcnt(" #n ")" ::: "memory")
#define PG8_WAIT_L(n) asm volatile("s_waitcnt lgkmcnt(" #n ")" ::: "memory")
#define PG8_BAR __builtin_amdgcn_s_barrier()
#define PG8_SCHED __builtin_amdgcn_sched_barrier(0)
    Unit cur, nxt; int ui = 0;
    if (!S.next(0, cur)) return;
    f32x4 acc[2][2][4][2];
#pragma unroll
    for (int a = 0; a < 2; ++a)
#pragma unroll
        for (int b = 0; b < 2; ++b)
#pragma unroll
            for (int m = 0; m < 4; ++m)
#pragma unroll
                for (int n = 0; n < 2; ++n) acc[a][b][m][n] = (f32x4){0.f, 0.f, 0.f, 0.f};
    bf16x8 At[4][2], B0[2][2], B1[2][2];
    const char* cA = (const char*)g.A + (size_t)cur.pm * tstep; const char* cB = (const char*)g.Bt + (size_t)cur.pn * tstep;
    S.a_ready(cur);
    if constexpr (SP2) {
        PG8_STAGE(PG8_SB(0, 0), cB, voffB); PG8_STAGE(PG8_SB(0, 1), cB + hstep, voffB); PG8_STAGE(PG8_SA(0, 0), cA, voffA); PG8_STAGE(PG8_SA(0, 1), cA + hstep, voffA);
        if (wr == 1) PG8_BAR;
        PG8_WAIT_V(2); PG8_BAR;
        PG8_STAGE(PG8_SB(1, 0), cB + kstep, voffB); PG8_STAGE(PG8_SA(1, 0), cA + kstep, voffA); PG8_STAGE(PG8_SB(1, 1), cB + hstep + kstep, voffB);
        PG8_WAIT_V(6); PG8_BAR;
    } else {
        PG8_STAGE(PG8_SB(0, 0), cB, voffB); PG8_STAGE(PG8_SA(0, 0), cA, voffA); PG8_STAGE(PG8_SB(0, 1), cB + hstep, voffB); PG8_STAGE(PG8_SA(0, 1), cA + hstep, voffA);
        if (wr == 1) PG8_BAR;
        PG8_WAIT_V(4); PG8_BAR;
        PG8_STAGE(PG8_SB(1, 0), cB + kstep, voffB); PG8_STAGE(PG8_SA(1, 0), cA + kstep, voffA); PG8_STAGE(PG8_SB(1, 1), cB + hstep + kstep, voffB);
        PG8_WAIT_V(6); PG8_BAR;
    }
    for (;;) {
        const bool has_next = S.next(ui + 1, nxt);
        const char* nA = has_next ? (const char*)g.A + (size_t)nxt.pm * tstep : cA; const char* nB = has_next ? (const char*)g.Bt + (size_t)nxt.pn * tstep : cB;
        for (int t = 0; t < nt; t += 2) {
            const bool last = (t == nt - 2);
            const char* a1 = cA + (size_t)(t + 1) * kstep;
            const char* a2 = last ? nA : cA + (size_t)(t + 2) * kstep; const char* b2 = last ? nB : cB + (size_t)(t + 2) * kstep;
            const char* a3 = a2 + kstep; const char* b3 = b2 + kstep;
            if (last && has_next) S.a_ready(nxt);
            if constexpr (SP2) {
            PG8_LDB(B0, 0, 0); PG8_LDB(B1, 0, 1); PG8_SCHED; PG8_LDA(At, 0, 0); PG8_STAGE(PG8_SA(1, 1), a1 + hstep, voffA);
            PG8_WAIT_V(8); PG8_WAIT_L(0); PG8_BAR; PG8_MMA(0, 0, At, B0); PG8_MMA(0, 1, At, B1); PG8_BAR; PG8_SCHED;
            PG8_LDA(At, 0, 1); PG8_STAGE(PG8_SB(0, 0), b2, voffB); PG8_STAGE(PG8_SB(0, 1), b2 + hstep, voffB); PG8_STAGE(PG8_SA(0, 0), a2, voffA);
            PG8_WAIT_V(8); PG8_WAIT_L(0); PG8_BAR; PG8_MMA(1, 0, At, B0); PG8_MMA(1, 1, At, B1); PG8_BAR; PG8_SCHED;
            PG8_LDB(B0, 1, 0); PG8_LDB(B1, 1, 1); PG8_SCHED; PG8_LDA(At, 1, 0); PG8_STAGE(PG8_SA(0, 1), a2 + hstep, voffA);
            PG8_WAIT_V(8); PG8_WAIT_L(0); PG8_BAR; PG8_MMA(0, 0, At, B0); PG8_MMA(0, 1, At, B1); PG8_BAR; PG8_SCHED;
            PG8_LDA(At, 1, 1); PG8_STAGE(PG8_SB(1, 0), b3, voffB); PG8_STAGE(PG8_SB(1, 1), b3 + hstep, voffB); PG8_STAGE(PG8_SA(1, 0), a3, voffA);
            PG8_WAIT_V(8); PG8_WAIT_L(0); PG8_BAR; PG8_MMA(1, 0, At, B0); PG8_MMA(1, 1, At, B1); PG8_BAR; PG8_SCHED;
            } else {
            PG8_LDB(B0, 0, 0); PG8_SCHED; PG8_LDA(At, 0, 0); PG8_STAGE(PG8_SA(1, 1), a1 + hstep, voffA);
            PG8_WAIT_L(8); PG8_BAR; PG8_WAIT_L(0); PG8_MMA(0, 0, At, B0); PG8_BAR; PG8_SCHED;
            PG8_LDB(B1, 0, 1); PG8_STAGE(PG8_SB(0, 0), b2, voffB);
            PG8_BAR; PG8_WAIT_L(0); PG8_MMA(0, 1, At, B1); PG8_BAR;
            PG8_LDA(At, 0, 1); PG8_STAGE(PG8_SA(0, 0), a2, voffA);
            PG8_BAR; PG8_WAIT_L(0); PG8_MMA(1, 0, At, B0); PG8_BAR; PG8_SCHED;
            PG8_STAGE(PG8_SB(0, 1), b2 + hstep, voffB);
            PG8_WAIT_V(6); PG8_BAR; PG8_MMA(1, 1, At, B1); PG8_BAR;
            PG8_LDB(B0, 1, 0); PG8_SCHED; PG8_LDA(At, 1, 0); PG8_STAGE(PG8_SA(0, 1), a2 + hstep, voffA);
            PG8_WAIT_L(8); PG8_BAR; PG8_WAIT_L(0); PG8_MMA(0, 0, At, B0); PG8_BAR; PG8_SCHED;
            PG8_LDB(B1, 1, 1); PG8_STAGE(PG8_SB(1, 0), b3, voffB);
            PG8_BAR; PG8_WAIT_L(0); PG8_MMA(0, 1, At, B1); PG8_BAR;
            PG8_LDA(At, 1, 1); PG8_STAGE(PG8_SA(1, 0), a3, voffA);
            PG8_BAR; PG8_WAIT_L(0); PG8_MMA(1, 0, At, B0); PG8_BAR; PG8_SCHED;
            PG8_STAGE(PG8_SB(1, 1), b3 + hstep, voffB);
            PG8_WAIT_V(6); PG8_BAR; PG8_MMA(1, 1, At, B1); PG8_BAR;
            }
        }
        if constexpr (ALIGN_EPI) { if (wr == 0) PG8_BAR; }
        if constexpr (!Epi::AFTER_DRAIN) { E(acc, cur, wr, wc, fr, fq); S.done(cur); }
        if (!has_next) break;
#pragma unroll
        for (int a = 0; a < 2; ++a)
#pragma unroll
            for (int b = 0; b < 2; ++b)
#pragma unroll
                for (int m = 0; m < 4; ++m)
#pragma unroll
                    for (int n = 0; n < 2; ++n) acc[a][b][m][n] = (f32x4){0.f, 0.f, 0.f, 0.f};
        cur = nxt; cA = nA; cB = nB; ++ui;
        if constexpr (ALIGN_EPI) { if (wr == 1) PG8_BAR; }
    }
    PG8_WAIT_V(0);
    if constexpr (!ALIGN_EPI) { if (wr == 0) PG8_BAR; }
    PG8_BAR;
    if constexpr (Epi::AFTER_DRAIN) { E.fused(acc, cur, wr, wc, fr, fq, lds, wid, lane); S.done(cur); }
#undef PG8_SA
#undef PG8_SB
#undef PG8_STAGE
#undef PG8_LDA
#undef PG8_LDB
#undef PG8_MMA
#undef PG8_WAIT_V
#undef PG8_WAIT_L
#undef PG8_BAR
#undef PG8_SCHED
}
}

#define LAS __attribute__((address_space(3)))
typedef unsigned short bf16_t;
typedef short bf16x8 __attribute__((ext_vector_type(8)));
typedef short s16x4 __attribute__((ext_vector_type(4)));
typedef float f32x4 __attribute__((ext_vector_type(4)));
typedef float f32x16 __attribute__((ext_vector_type(16)));
typedef unsigned u32x4 __attribute__((ext_vector_type(4)));
typedef unsigned u32x2 __attribute__((ext_vector_type(2)));
typedef float f32x2_t __attribute__((ext_vector_type(2))); typedef __bf16 bf16x2_t __attribute__((ext_vector_type(2)));
__device__ __forceinline__ unsigned cvt_pk_bf16(float lo, float hi) { f32x2_t v = {lo, hi}; bf16x2_t b = __builtin_convertvector(v, bf16x2_t); return __builtin_bit_cast(unsigned, b); }

constexpr int DM = 1024, SEQ = 16384, NB = 2, DB = 32, DS = 16, PAST = 4096, LA = 576;
constexpr int MP = NB * SEQ, MS = DB * DS, MT = MP + MS;
constexpr int DFF = 2816, NUP = 2 * DFF, NIN = 3072, NGATE = 2048, NING = NIN + NGATE, MEMT = 256;
constexpr float EPS = 1e-6f, LOG2E = 1.4426950408889634f;
static_assert(MT % 256 == 0, "rows");

constexpr size_t O_YP = 0, O_YS = O_YP + (size_t)MP * DM, O_AKP = O_YS + (size_t)MS * DM, O_AVP = O_AKP + (size_t)NB * LA * 512,
    O_BKP = O_AVP + (size_t)NB * LA * 512, O_BVP = O_BKP + (size_t)MP * 512, O_MKP = O_BVP + (size_t)MP * 512, O_MVP = O_MKP + (size_t)NB * MEMT * DM,
    O_AKS = O_MVP + (size_t)NB * MEMT * DM, O_AVS = O_AKS + (size_t)DB * LA * 512, O_BKS = O_AVS + (size_t)DB * LA * 512, O_BVS = O_BKS + (size_t)MS * 512,
    O_END = O_BVS + (size_t)MS * 512;

constexpr size_t MiB = 1u << 20;
constexpr size_t WS_CTL = 0;
constexpr size_t WS_UP1 = 1 * MiB, WS_DN1 = WS_UP1 + 11 * MiB, WS_ING = WS_DN1 + 6 * MiB, WS_BRA = WS_ING + 10 * MiB, WS_BRB = WS_BRA + 1 * MiB,
    WS_OUT = WS_BRB + 1 * MiB, WS_MQ = WS_OUT + 2 * MiB, WS_MKV = WS_MQ + 2 * MiB, WS_MO = WS_MKV + 4 * MiB, WS_UP2 = WS_MO + 2 * MiB, WS_DN2 = WS_UP2 + 11 * MiB,
    WS_MKB = WS_DN2 + 6 * MiB, WS_MEMN = WS_MKB + 2 * MiB, WS_XN = WS_MEMN + 1 * MiB, WS_ACT = WS_XN + 65 * MiB, WS_DF = WS_ACT + 179 * MiB,
    WS_H = WS_DF + 130 * MiB, WS_QKV = WS_H + 130 * MiB, WS_GATES = WS_QKV + 195 * MiB, WS_YA = WS_GATES + 130 * MiB, WS_YB = WS_YA + 33 * MiB, WS_MKS = WS_YB + 33 * MiB, WS_END = WS_MKS + 32 * MiB;
static_assert(WS_END <= 1024 * MiB, "workspace map");

constexpr int LDS_BYTES = 147456;
constexpr int LDS_QW = 140 * 1024;

#ifndef REPG
#define REPG 1
#endif
#ifndef REPB
#define REPB 1
#endif
struct Args { const float* in[26]; float* out; unsigned char* ws; int ph_lo, ph_hi; };

__device__ __forceinline__ float bf_lo(unsigned u) { return __uint_as_float(u << 16); }
__device__ __forceinline__ float bf_hi(unsigned u) { return __uint_as_float(u & 0xffff0000u); }
__device__ __forceinline__ float wave_sum(float v) {
#pragma unroll
    for (int o = 1; o < 64; o <<= 1) v += __shfl_xor(v, o);
    return v;
}
__device__ __forceinline__ u32x4 pack8(const float* v) {
    u32x4 w; w.x = cvt_pk_bf16(v[0], v[1]); w.y = cvt_pk_bf16(v[2], v[3]); w.z = cvt_pk_bf16(v[4], v[5]); w.w = cvt_pk_bf16(v[6], v[7]); return w;
}

#define EPI_ROWS_BEGIN _Pragma("unroll") for (int ai = 0; ai < 2; ++ai) _Pragma("unroll") for (int m = 0; m < 4; ++m) { const int row = u.pm * 256 + ai * 128 + wr * 64 + m * 16 + fr;
#define EPI_ROWS_END }
#define EPI_V8(bj) float v[8]; { const f32x4 a0 = acc[ai][bj][m][0], a1 = acc[ai][bj][m][1]; v[0] = a0[0]; v[1] = a0[1]; v[2] = a0[2]; v[3] = a0[3]; v[4] = a1[0]; v[5] = a1[1]; v[6] = a1[2]; v[7] = a1[3]; }
typedef const f32x4 (&AccRef)[2][2][4][2];

struct EpiSwiglu {
    static constexpr bool PERM = true, AFTER_DRAIN = false; bf16_t* O;
    __device__ __forceinline__ void operator()(AccRef acc, const pg8::Unit& u, int wr, int wc, int fr, int fq) const {
        const int col = u.pn * 128 + wc * 32 + 8 * fq;
        EPI_ROWS_BEGIN
            float o[8];
#pragma unroll
            for (int n = 0; n < 2; ++n)
#pragma unroll
                for (int i = 0; i < 4; ++i) { const float g = acc[ai][0][m][n][i], up = acc[ai][1][m][n][i];
                    const float sg = g * __builtin_amdgcn_rcpf(1.0f + __builtin_amdgcn_exp2f(-g * LOG2E)); o[n * 4 + i] = sg * up; }
            *(u32x4*)(O + (size_t)row * DFF + col) = pack8(o);
        EPI_ROWS_END
    }
};
struct EpiF32 {
    static constexpr bool PERM = true, AFTER_DRAIN = false; float* O; int ldc;
    __device__ __forceinline__ void operator()(AccRef acc, const pg8::Unit& u, int wr, int wc, int fr, int fq) const {
        EPI_ROWS_BEGIN
#pragma unroll
            for (int bj = 0; bj < 2; ++bj) { float* p = O + (size_t)row * ldc + u.pn * 256 + bj * 128 + wc * 32 + 8 * fq;
                *(f32x4*)p = acc[ai][bj][m][0]; *(f32x4*)(p + 4) = acc[ai][bj][m][1]; }
        EPI_ROWS_END
    }
};
struct EpiBf16 {
    static constexpr bool PERM = true, AFTER_DRAIN = false; bf16_t* O; int ldc;
    __device__ __forceinline__ void operator()(AccRef acc, const pg8::Unit& u, int wr, int wc, int fr, int fq) const {
        EPI_ROWS_BEGIN
#pragma unroll
            for (int bj = 0; bj < 2; ++bj) { EPI_V8(bj); *(u32x4*)(O + (size_t)row * ldc + u.pn * 256 + bj * 128 + wc * 32 + 8 * fq) = pack8(v); }
        EPI_ROWS_END
    }
};
struct EpiBrA {
    static constexpr bool PERM = true, AFTER_DRAIN = false; const bf16_t* G; float* T;
    __device__ __forceinline__ void operator()(AccRef acc, const pg8::Unit& u, int wr, int wc, int fr, int fq) const {
        EPI_ROWS_BEGIN
#pragma unroll
            for (int bj = 0; bj < 2; ++bj) { const int col = u.pn * 256 + bj * 128 + wc * 32 + 8 * fq; EPI_V8(bj);
                const u32x4 g = *(const u32x4*)(G + (size_t)row * NGATE + col);
                f32x4 o0, o1; o0[0] = v[0] * bf_lo(g.x); o0[1] = v[1] * bf_hi(g.x); o0[2] = v[2] * bf_lo(g.y); o0[3] = v[3] * bf_hi(g.y);
                o1[0] = v[4] * bf_lo(g.z); o1[1] = v[5] * bf_hi(g.z); o1[2] = v[6] * bf_lo(g.w); o1[3] = v[7] * bf_hi(g.w);
                float* p = T + (size_t)row * DM + col; *(f32x4*)p = o0; *(f32x4*)(p + 4) = o1; }
        EPI_ROWS_END
    }
};
struct EpiBrB {
    static constexpr bool PERM = true, AFTER_DRAIN = false; const bf16_t* G; const float* T; bf16_t* O;
    __device__ __forceinline__ void operator()(AccRef acc, const pg8::Unit& u, int wr, int wc, int fr, int fq) const {
        EPI_ROWS_BEGIN
#pragma unroll
            for (int bj = 0; bj < 2; ++bj) { const int col = u.pn * 256 + bj * 128 + wc * 32 + 8 * fq; EPI_V8(bj);
                const u32x4 g = *(const u32x4*)(G + (size_t)row * NGATE + DM + col);
                const float* p = T + (size_t)row * DM + col; const f32x4 t0 = *(const f32x4*)p, t1 = *(const f32x4*)(p + 4);
                float o[8]; o[0] = t0[0] + v[0] * bf_lo(g.x); o[1] = t0[1] + v[1] * bf_hi(g.x); o[2] = t0[2] + v[2] * bf_lo(g.y); o[3] = t0[3] + v[3] * bf_hi(g.y);
                o[4] = t1[0] + v[4] * bf_lo(g.z); o[5] = t1[1] + v[5] * bf_hi(g.z); o[6] = t1[2] + v[6] * bf_lo(g.w); o[7] = t1[3] + v[7] * bf_hi(g.w);
                *(u32x4*)(O + (size_t)row * DM + col) = pack8(o); }
        EPI_ROWS_END
    }
};
struct EpiMemKV {
    static constexpr bool PERM = true, AFTER_DRAIN = false; float* out; bf16_t* MKB;
    __device__ __forceinline__ void operator()(AccRef acc, const pg8::Unit& u, int wr, int wc, int fr, int fq) const {
        EPI_ROWS_BEGIN
#pragma unroll
            for (int bj = 0; bj < 2; ++bj) { const int col = u.pn * 256 + bj * 128 + wc * 32 + 8 * fq; EPI_V8(bj);
                float* p = out + (col < DM ? O_MKP + (size_t)row * DM + col : O_MVP + (size_t)row * DM + (col - DM));
                *(f32x4*)p = acc[ai][bj][m][0]; *(f32x4*)(p + 4) = acc[ai][bj][m][1];
                *(u32x4*)(MKB + (size_t)row * 2048 + col) = pack8(v); }
        EPI_ROWS_END
    }
};
struct EpiInGate {
    static constexpr bool PERM = true, AFTER_DRAIN = false; bf16_t* QKV; bf16_t* G; const float* bg; float* out; bf16_t* VTA; bf16_t* VTB;
    __device__ __forceinline__ void operator()(AccRef acc, const pg8::Unit& u, int wr, int wc, int fr, int fq) const {
        const int region = u.pn >> 1;
        EPI_ROWS_BEGIN
            const bool samp = row >= MP;
#pragma unroll
            for (int bj = 0; bj < 2; ++bj) { const int col = u.pn * 256 + bj * 128 + wc * 32 + 8 * fq; EPI_V8(bj);
                if (u.pn < 12) {
                    const int cc = col - region * 512; float* p = nullptr;
                    if (region != 2 && region != 5) *(u32x4*)(QKV + (size_t)row * NIN + col) = pack8(v);
                    else if (!samp) { const u32x4 w8 = pack8(v); bf16_t* vt = (region == 2 ? VTA : VTB) + ((size_t)((row >> 14) * 512 + cc) * SEQ + (row & (SEQ - 1)));
                        vt[0 * (size_t)SEQ] = (bf16_t)(w8.x & 0xffffu); vt[1 * (size_t)SEQ] = (bf16_t)(w8.x >> 16); vt[2 * (size_t)SEQ] = (bf16_t)(w8.y & 0xffffu); vt[3 * (size_t)SEQ] = (bf16_t)(w8.y >> 16);
                        vt[4 * (size_t)SEQ] = (bf16_t)(w8.z & 0xffffu); vt[5 * (size_t)SEQ] = (bf16_t)(w8.z >> 16); vt[6 * (size_t)SEQ] = (bf16_t)(w8.w & 0xffffu); vt[7 * (size_t)SEQ] = (bf16_t)(w8.w >> 16); }
                    if (region == 1 || region == 2) {
                        if (!samp) { const int n = row >> 14, t = row & (SEQ - 1); if (t >= SEQ - LA) p = out + (region == 1 ? O_AKP : O_AVP) + ((size_t)(n * LA + t - (SEQ - LA)) * 512 + cc); }
                        else { const int rs = row - MP, n = rs >> 4, t = rs & 15; p = out + (region == 1 ? O_AKS : O_AVS) + ((size_t)(n * LA + (LA - DS) + t) * 512 + cc); }
                    } else if (region == 4 || region == 5) {
                        p = samp ? out + (region == 4 ? O_BKS : O_BVS) + ((size_t)(row - MP) * 512 + cc) : out + (region == 4 ? O_BKP : O_BVP) + ((size_t)row * 512 + cc);
                    }
                    if (p) { *(f32x4*)p = acc[ai][bj][m][0]; *(f32x4*)(p + 4) = acc[ai][bj][m][1]; }
                } else {
                    const int gc = col - NIN; const f32x4 b0 = *(const f32x4*)(bg + gc), b1 = *(const f32x4*)(bg + gc + 4);
                    float o[8];
#pragma unroll
                    for (int i = 0; i < 8; ++i) { const float z = v[i] + (i < 4 ? b0[i & 3] : b1[i & 3]); o[i] = __builtin_amdgcn_rcpf(1.0f + __builtin_amdgcn_exp2f(-z * LOG2E)); }
                    *(u32x4*)(G + (size_t)row * NGATE + gc) = pack8(o);
                }
            }
        EPI_ROWS_END
    }
};

template <int K, class F> __device__ __forceinline__ void small_gemm(LAS unsigned char* lds, const bf16_t* A, const bf16_t* Bt, int ntn, bool swiglu, int t0, int G, int wave, int lane, const F& f) {
    constexpr int KS = K / 8;
    static_assert(KS % 16 == 0, "K slice");
    const int r32 = lane & 31, hi = lane >> 5;
    LAS float* P = (LAS float*)lds;
    for (int wt = t0; wt < 16 * ntn; wt += G) {
        const int tm = wt & 15, tn = wt >> 4;
        const int brow0 = swiglu ? (tn >> 2) * 256 + (tn & 3) * 32 : tn * 64, brow1 = brow0 + (swiglu ? 128 : 32);
        const int ccol = swiglu ? (tn >> 2) * 128 + (tn & 3) * 32 : tn * 64;
        const bf16_t* ap = A + (size_t)(tm * 32 + r32) * K + wave * KS + hi * 8; const bf16_t* b0 = Bt + (size_t)(brow0 + r32) * K + wave * KS + hi * 8; const bf16_t* b1 = Bt + (size_t)(brow1 + r32) * K + wave * KS + hi * 8;
        f32x16 acc0, acc1;
#pragma unroll
        for (int r = 0; r < 16; ++r) { acc0[r] = 0.f; acc1[r] = 0.f; }
#pragma unroll 8
        for (int k = 0; k < KS; k += 16) { const bf16x8 a = *(const bf16x8*)(ap + k), x0 = *(const bf16x8*)(b0 + k), x1 = *(const bf16x8*)(b1 + k);
            acc0 = __builtin_amdgcn_mfma_f32_32x32x16_bf16(x0, a, acc0, 0, 0, 0); acc1 = __builtin_amdgcn_mfma_f32_32x32x16_bf16(x1, a, acc1, 0, 0, 0); }
#pragma unroll
        for (int r = 0; r < 16; ++r) { P[(wave * 32 + r) * 64 + lane] = acc0[r]; P[(wave * 32 + 16 + r) * 64 + lane] = acc1[r]; }
        __syncthreads();
        if (wave < 4) { const int g = wave; f32x4 a = {0.f, 0.f, 0.f, 0.f}, b = {0.f, 0.f, 0.f, 0.f};
#pragma unroll
            for (int w = 0; w < 8; ++w)
#pragma unroll
                for (int i = 0; i < 4; ++i) { a[i] += P[(w * 32 + 4 * g + i) * 64 + lane]; b[i] += P[(w * 32 + 16 + 4 * g + i) * 64 + lane]; }
            f(tm * 32 + r32, ccol + 8 * g + 4 * hi, a, b); }
        __syncthreads();
    }
}
__device__ __forceinline__ u32x2 pack4(f32x4 v) { u32x2 w; w.x = cvt_pk_bf16(v.x, v.y); w.y = cvt_pk_bf16(v.z, v.w); return w; }
__device__ __forceinline__ f32x4 unpack4(u32x2 w) { return (f32x4){bf_lo(w.x), bf_hi(w.x), bf_lo(w.y), bf_hi(w.y)}; }
__device__ __forceinline__ float sigm(float z) { return __builtin_amdgcn_rcpf(1.0f + __builtin_amdgcn_exp2f(-z * LOG2E)); }
struct SSwiglu { bf16_t* O;
    __device__ __forceinline__ void operator()(int row, int col, f32x4 g, f32x4 up) const { f32x4 o; o.x = g.x * sigm(g.x) * up.x; o.y = g.y * sigm(g.y) * up.y; o.z = g.z * sigm(g.z) * up.z; o.w = g.w * sigm(g.w) * up.w;
        *(u32x2*)(O + (size_t)row * DFF + col) = pack4(o); } };
struct SBf16 { bf16_t* O; int ldc;
    __device__ __forceinline__ void operator()(int row, int col, f32x4 a, f32x4 b) const { bf16_t* p = O + (size_t)row * ldc + col; *(u32x2*)p = pack4(a); *(u32x2*)(p + 32) = pack4(b); } };
struct SBrA { const bf16_t* G; float* T;
    __device__ __forceinline__ void operator()(int row, int col, f32x4 a, f32x4 b) const { const bf16_t* g = G + (size_t)row * NGATE + col; float* t = T + (size_t)row * DM + col;
        *(f32x4*)t = a * unpack4(*(const u32x2*)g); *(f32x4*)(t + 32) = b * unpack4(*(const u32x2*)(g + 32)); } };
struct SBrB { const bf16_t* G; const float* T; bf16_t* O;
    __device__ __forceinline__ void operator()(int row, int col, f32x4 a, f32x4 b) const { const bf16_t* g = G + (size_t)row * NGATE + DM + col; const float* t = T + (size_t)row * DM + col; bf16_t* o = O + (size_t)row * DM + col;
        *(u32x2*)o = pack4(*(const f32x4*)t + a * unpack4(*(const u32x2*)g)); *(u32x2*)(o + 32) = pack4(*(const f32x4*)(t + 32) + b * unpack4(*(const u32x2*)(g + 32))); } };
struct SMemKV { float* out; bf16_t* MK;
    __device__ __forceinline__ void one(int row, int col, f32x4 v) const { *(f32x4*)(out + (col < DM ? O_MKP + (size_t)row * DM + col : O_MVP + (size_t)row * DM + (col - DM))) = v; *(u32x2*)(MK + (size_t)row * 2048 + col) = pack4(v); }
    __device__ __forceinline__ void operator()(int row, int col, f32x4 a, f32x4 b) const { one(row, col, a); one(row, col + 32, b); } };
struct SInGate { bf16_t* Q; bf16_t* G; const float* bg; float* out;
    __device__ __forceinline__ void one(int row, int col, f32x4 v) const {
        if (col < NIN) { const int region = col >> 9, cc = col & 511, n = row >> 4, t = row & 15;
            if (region != 2 && region != 5) *(u32x2*)(Q + (size_t)row * NIN + col) = pack4(v);
            if (region == 1 || region == 2) *(f32x4*)(out + (region == 1 ? O_AKS : O_AVS) + ((size_t)(n * LA + (LA - DS) + t) * 512 + cc)) = v;
            else if (region == 4 || region == 5) *(f32x4*)(out + (region == 4 ? O_BKS : O_BVS) + ((size_t)row * 512 + cc)) = v;
        } else { const int gc = col - NIN; const f32x4 b = *(const f32x4*)(bg + gc); f32x4 o; o.x = sigm(v.x + b.x); o.y = sigm(v.y + b.y); o.z = sigm(v.z + b.z); o.w = sigm(v.w + b.w);
            *(u32x2*)(G + (size_t)row * NGATE + gc) = pack4(o); } }
    __device__ __forceinline__ void operator()(int row, int col, f32x4 a, f32x4 b) const { one(row, col, a); one(row, col + 32, b); } };

__device__ __forceinline__ unsigned f2bf(float f) { unsigned u = __builtin_bit_cast(unsigned, f); return (u + 0x7fffu + ((u >> 16) & 1u)) >> 16; }
__device__ __forceinline__ unsigned pk2(float lo, float hi) { return f2bf(lo) | (f2bf(hi) << 16); }
__device__ __forceinline__ int up_row(int n) { return n < DFF ? ((n >> 7) << 8) + (n & 127) : ((((n - DFF) >> 7) << 8) + 128 + ((n - DFF) & 127)); }
template <bool UP> __device__ __forceinline__ void transpose_item(const float* W, int K, int N, bf16_t* WT, int row_off, LAS float* scr, int item, int lane) {
    const int nblk = N / 32, kb = item / nblk, nb = item % nblk, k0 = 64 * kb, n0 = 32 * nb;
#pragma unroll 8
    for (int i = 0; i < 32; ++i) { const int kk = 2 * i + (lane >> 5); scr[kk * 33 + (lane & 31)] = W[(size_t)(k0 + kk) * N + n0 + (lane & 31)]; }
    asm volatile("s_waitcnt lgkmcnt(0)" ::: "memory");
    const int c = lane & 7;
    const int r0 = UP ? up_row(n0) : row_off + n0;
#pragma unroll
    for (int j = 0; j < 4; ++j) { const int n = (lane >> 3) + 8 * j; const LAS float* s = scr + (8 * c) * 33 + n;
        u32x4 o; o.x = pk2(s[0 * 33], s[1 * 33]); o.y = pk2(s[2 * 33], s[3 * 33]); o.z = pk2(s[4 * 33], s[5 * 33]); o.w = pk2(s[6 * 33], s[7 * 33]);
        *(u32x4*)(WT + (size_t)(r0 + n) * K + k0 + 8 * c) = o; }
    asm volatile("s_waitcnt lgkmcnt(0)" ::: "memory");
}
__device__ __forceinline__ void rms_row_to_bf16(const float* xrow, const float* g, bf16_t* orow, int lane) {
    const f32x4* xr = (const f32x4*)xrow + lane; const f32x4* gr = (const f32x4*)g + lane;
    f32x4 v[4]; float s = 0.f;
#pragma unroll
    for (int j = 0; j < 4; ++j) { v[j] = xr[64 * j]; s += (v[j].x * v[j].x + v[j].y * v[j].y) + (v[j].z * v[j].z + v[j].w * v[j].w); }
    const float rstd = 1.0f / sqrtf(wave_sum(s) * (1.f / DM) + EPS);
    u32x2* o8 = (u32x2*)orow + lane;
#pragma unroll
    for (int j = 0; j < 4; ++j) { const f32x4 gg = gr[64 * j]; u32x2 w; w.x = cvt_pk_bf16(v[j].x * rstd * gg.x, v[j].y * rstd * gg.y); w.y = cvt_pk_bf16(v[j].z * rstd * gg.z, v[j].w * rstd * gg.w); o8[64 * j] = w; }
}
__device__ __forceinline__ f32x4 ld_bf4(const bf16_t* row, int lane, int j) { const u32x2 w = ((const u32x2*)row + lane)[64 * j]; return (f32x4){bf_lo(w.x), bf_hi(w.x), bf_lo(w.y), bf_hi(w.y)}; }
__device__ __forceinline__ void st_bf4(bf16_t* row, int lane, int j, f32x4 v) { u32x2 w; w.x = cvt_pk_bf16(v.x, v.y); w.y = cvt_pk_bf16(v.z, v.w); ((u32x2*)row + lane)[64 * j] = w; }
template <bool BASE_F32, bool FINAL> __device__ __forceinline__ void res_row(const void* base, const bf16_t* d, const float* gres, float coef, float* outp, bf16_t* hout, const float* gnorm, bf16_t* xn, int lane) {
    const f32x4* gr = (const f32x4*)gres + lane;
    f32x4 dv[4], hv[4]; float s = 0.f;
#pragma unroll
    for (int j = 0; j < 4; ++j) { dv[j] = ld_bf4(d, lane, j); hv[j] = BASE_F32 ? ((const f32x4*)base + lane)[64 * j] : ld_bf4((const bf16_t*)base, lane, j);
        s += (dv[j].x * dv[j].x + dv[j].y * dv[j].y) + (dv[j].z * dv[j].z + dv[j].w * dv[j].w); }
    const float rs = coef / sqrtf(wave_sum(s) * (1.f / DM) + EPS);
    float s2 = 0.f;
#pragma unroll
    for (int j = 0; j < 4; ++j) { const f32x4 gg = gr[64 * j]; hv[j] = hv[j] + dv[j] * gg * rs; s2 += (hv[j].x * hv[j].x + hv[j].y * hv[j].y) + (hv[j].z * hv[j].z + hv[j].w * hv[j].w);
        if (FINAL) ((f32x4*)outp + lane)[64 * j] = hv[j]; else st_bf4(hout, lane, j, hv[j]); }
    if (!FINAL) {
        const float rstd = 1.0f / sqrtf(wave_sum(s2) * (1.f / DM) + EPS);
        const f32x4* gn = (const f32x4*)gnorm + lane;
#pragma unroll
        for (int j = 0; j < 4; ++j) { const f32x4 gg = gn[64 * j]; st_bf4(xn, lane, j, hv[j] * gg * rstd); }
    }
}

struct AUnit {
    const bf16_t* Q; int ldq; int nq; int qpos0;
    const void* K0; const void* V0; int ld0; int nt0;
    const void* K1; const void* V1; int ld1; int n1; int ldv1;
    int kpos0, tb, te, nkeys, head;
    bf16_t* O; int ldo;
};
template <bool F32> struct Piece;
template <> struct Piece<true> { f32x4 a, b; };
template <> struct Piece<false> { u32x4 a; };
__device__ __forceinline__ void piece_load(Piece<true>& p, const void* base, size_t eoff) { const float* s = (const float*)base + eoff; p.a = *(const f32x4*)s; p.b = *(const f32x4*)(s + 4); }
__device__ __forceinline__ void piece_load(Piece<false>& p, const void* base, size_t eoff) { p.a = *(const u32x4*)((const bf16_t*)base + eoff); }
__device__ __forceinline__ u32x4 piece_bf16(const Piece<true>& p) { u32x4 w; w.x = cvt_pk_bf16(p.a[0], p.a[1]); w.y = cvt_pk_bf16(p.a[2], p.a[3]); w.z = cvt_pk_bf16(p.b[0], p.b[1]); w.w = cvt_pk_bf16(p.b[2], p.b[3]); return w; }
__device__ __forceinline__ u32x4 piece_bf16(const Piece<false>& p) { return p.a; }

template <int MODE, bool F32>
__device__ __forceinline__ void attn_unit(LAS unsigned char* lds, const AUnit& u, const float lam, const float* __restrict__ relb, const float* __restrict__ subg) {
    constexpr bool VT = (MODE != 2) && !F32;
    constexpr int DQK = (MODE == 2) ? 256 : 64, KW = (MODE == 2) ? 256 : 128, DV = (MODE == 0) ? 64 : 128, VW = (MODE == 2) ? 256 : 128;
    constexpr int NSUB = 1, TK = 64 * NSUB;
    constexpr int KSTRB = KW * 2 + 16, VSTRB = (TK + 4) * 2, VOFFB = TK * KSTRB, STAGE = VOFFB + VW * VSTRB;
    constexpr int NKP = TK * (KW / 8) / 512, NVP = VT ? VW * (TK / 8) / 512 : VW / 64, NDB = DV / 32;
    constexpr float SCL = ((MODE == 2) ? 0.0625f : 0.125f) * LOG2E, THR = 8.0f;
    const int tid = threadIdx.x, lane = tid & 63, wid = __builtin_amdgcn_readfirstlane(tid >> 6), r32 = lane & 31, hi = lane >> 5;
    const int qg = wid >> 1, s = wid & 1;
    const int koff = (KW == 2 * DQK) ? s * DQK : 0, voff = (VW == 2 * DV) ? s * DV : 0;
    const bool active = (qg * 32 < u.nq);
    const int qrow = qg * 32 + r32, qrow_c = qrow < u.nq ? qrow : u.nq - 1;
    const bf16_t* qp = u.Q + (size_t)qrow_c * u.ldq + ((MODE == 2) ? 0 : s * 64) + hi * 8;
    bf16x8 qf[4];
    if (MODE != 2 && !F32) {
#pragma unroll
        for (int d0 = 0; d0 < 4; ++d0) qf[d0] = *(const bf16x8*)(qp + d0 * 16);
    }
    const int pq = u.qpos0 + qrow;
    const int cq = (u.qpos0 + qg * 32) >> 6;
    float slope2 = 0.f;
    int kaA = 0, kaB = 0, qau = 0;
    if (MODE == 1) {
        slope2 = __builtin_amdgcn_exp2f(-2.0f * (float)(u.head + 1)) * LOG2E;
        if (!F32 && hi == 0) { kaA = (int)(__float_as_uint((float)r32) >> 16); kaB = (int)(__float_as_uint((float)(32 + r32)) >> 16);
            qau = (int)(__float_as_uint(__builtin_amdgcn_exp2f((float)(1 - 2 * u.head))) >> 16); }
    }
    const float* rb = relb + (size_t)(u.head + s) * 257;
    float m_run = -1e30f, l_run = 0.f;
    f32x16 o[NDB];
#pragma unroll
    for (int db = 0; db < NDB; ++db)
#pragma unroll
        for (int r = 0; r < 16; ++r) o[db][r] = 0.f;
    Piece<F32> kr[NKP], vr[NVP];
#define ATT_LOAD(t) do { const int t_ = (t); const bool s0_ = t_ < u.nt0; const void* kb_ = s0_ ? u.K0 : u.K1; const void* vb_ = s0_ ? u.V0 : u.V1; const int ld_ = s0_ ? u.ld0 : u.ld1; \
        const int rb_ = s0_ ? 64 * t_ : 64 * (t_ - u.nt0); const int lim_ = s0_ ? 0x7fffffff : u.n1 - 1; \
        _Pragma("unroll") for (int i_ = 0; i_ < NKP; ++i_) { const int p_ = tid + 512 * i_; int row_ = rb_ + p_ / (KW / 8); row_ = row_ < lim_ ? row_ : lim_; piece_load(kr[i_], kb_, (size_t)row_ * ld_ + (p_ % (KW / 8)) * 8); } \
        if (VT) { _Pragma("unroll") for (int i_ = 0; i_ < NVP; ++i_) { const int p_ = tid + 512 * i_; piece_load(vr[i_], u.V1, (size_t)(p_ / (TK / 8)) * u.ldv1 + 64 * t_ + (p_ % (TK / 8)) * 8); } } \
        else { _Pragma("unroll") for (int i_ = 0; i_ < NVP; ++i_) { const int w_ = (tid >> 6) + 8 * i_; int row_ = rb_ + 16 * (w_ & 3) + (lane & 15); row_ = row_ < lim_ ? row_ : lim_; piece_load(vr[i_], vb_, (size_t)row_ * ld_ + (4 * (w_ >> 2) + (lane >> 4)) * 8); } } } while (0)
#define ATT_WRITE(buf) do { LAS unsigned char* b_ = (buf); \
        _Pragma("unroll") for (int i_ = 0; i_ < NKP; ++i_) { const int p_ = tid + 512 * i_; *(LAS u32x4*)(b_ + (p_ / (KW / 8)) * KSTRB + (p_ % (KW / 8)) * 16) = piece_bf16(kr[i_]); } \
        if (VT) { _Pragma("unroll") for (int i_ = 0; i_ < NVP; ++i_) { const int p_ = tid + 512 * i_; const u32x4 w4_ = piece_bf16(vr[i_]); LAS unsigned char* vp_ = b_ + VOFFB + (p_ / (TK / 8)) * VSTRB + (p_ % (TK / 8)) * 16; \
                *(LAS u32x2*)vp_ = (u32x2){w4_.x, w4_.y}; *(LAS u32x2*)(vp_ + 8) = (u32x2){w4_.z, w4_.w}; } } \
        else { _Pragma("unroll") for (int i_ = 0; i_ < NVP; ++i_) { const int w_ = (tid >> 6) + 8 * i_; const int row_ = 16 * (w_ & 3) + (lane & 15), c8_ = 4 * (w_ >> 2) + (lane >> 4); const u32x4 b4_ = piece_bf16(vr[i_]); \
                LAS bf16_t* vp_ = (LAS bf16_t*)(b_ + VOFFB + (c8_ * 8) * VSTRB) + row_; \
                vp_[0 * (VSTRB / 2)] = (bf16_t)(b4_.x & 0xffffu); vp_[1 * (VSTRB / 2)] = (bf16_t)(b4_.x >> 16); vp_[2 * (VSTRB / 2)] = (bf16_t)(b4_.y & 0xffffu); vp_[3 * (VSTRB / 2)] = (bf16_t)(b4_.y >> 16); \
                vp_[4 * (VSTRB / 2)] = (bf16_t)(b4_.z & 0xffffu); vp_[5 * (VSTRB / 2)] = (bf16_t)(b4_.z >> 16); vp_[6 * (VSTRB / 2)] = (bf16_t)(b4_.w & 0xffffu); vp_[7 * (VSTRB / 2)] = (bf16_t)(b4_.w >> 16); } } } while (0)
    const int nt = (u.te - u.tb) / NSUB;
    constexpr bool ASC = false;
    ATT_LOAD(ASC ? u.tb : u.te - NSUB);
    ATT_WRITE(lds);
    if (nt > 1) ATT_LOAD(ASC ? u.tb + NSUB : u.te - 2 * NSUB);
    __syncthreads();
    for (int j = 0; j < nt; ++j) {
        const int t0 = ASC ? u.tb + NSUB * j : u.te - NSUB * (j + 1);
        LAS unsigned char* cur = lds + (j & 1) * STAGE;
        if (j + 1 < nt) ATT_WRITE(lds + ((j + 1) & 1) * STAGE);
        if (!F32 && j + 2 < nt) ATT_LOAD(ASC ? t0 + 2 * NSUB : t0 - 2 * NSUB);
#pragma unroll
        for (int sb_ = 0; sb_ < NSUB; ++sb_) {
        const int sub = ASC ? sb_ : NSUB - 1 - sb_;
        const int t = t0 + sub;
        LAS unsigned char* curK = cur + sub * 64 * KSTRB;
        const int ck = (u.kpos0 + 64 * t) >> 6;
        bool vis = active;
        if (MODE == 0) vis = vis && (ck <= cq) && (ck >= cq - 8);
        if (MODE == 1) vis = vis && (ck <= cq);
        if (vis) {
            f32x16 sA, sB;
#pragma unroll
            for (int r = 0; r < 16; ++r) { sA[r] = 0.f; sB[r] = 0.f; }
            const bool aug = (MODE == 1) && !F32 && (ck < cq);
            if (MODE == 1 && !F32 && aug) {
                int a_ = kaA, b_ = kaB, q_ = qau; asm volatile("" : "+v"(a_), "+v"(b_), "+v"(q_));
                const u32x4 fa = {(unsigned)a_, 0u, 0u, 0u}, fb = {(unsigned)b_, 0u, 0u, 0u}, fq = {(unsigned)q_, 0u, 0u, 0u};
                sA = __builtin_amdgcn_mfma_f32_32x32x16_bf16(__builtin_bit_cast(bf16x8, fa), __builtin_bit_cast(bf16x8, fq), sA, 0, 0, 0);
                sB = __builtin_amdgcn_mfma_f32_32x32x16_bf16(__builtin_bit_cast(bf16x8, fb), __builtin_bit_cast(bf16x8, fq), sB, 0, 0, 0);
            }
            if (MODE != 2) {
#pragma unroll
                for (int d0 = 0; d0 < 4; ++d0) {
                    const bf16x8 ka = *(const LAS bf16x8*)(curK + r32 * KSTRB + (koff + d0 * 16 + hi * 8) * 2);
                    const bf16x8 kb = *(const LAS bf16x8*)(curK + (32 + r32) * KSTRB + (koff + d0 * 16 + hi * 8) * 2);
                    const bf16x8 q = F32 ? *(const bf16x8*)(qp + d0 * 16) : qf[d0];
                    sA = __builtin_amdgcn_mfma_f32_32x32x16_bf16(ka, q, sA, 0, 0, 0);
                    sB = __builtin_amdgcn_mfma_f32_32x32x16_bf16(kb, q, sB, 0, 0, 0);
                }
            } else {
#pragma unroll 4
                for (int d0 = 0; d0 < 16; ++d0) {
                    const bf16x8 q = *(const bf16x8*)(qp + d0 * 16);
                    const bf16x8 ka = *(const LAS bf16x8*)(curK + r32 * KSTRB + (koff + d0 * 16 + hi * 8) * 2);
                    const bf16x8 kb = *(const LAS bf16x8*)(curK + (32 + r32) * KSTRB + (koff + d0 * 16 + hi * 8) * 2);
                    sA = __builtin_amdgcn_mfma_f32_32x32x16_bf16(ka, q, sA, 0, 0, 0);
                    sB = __builtin_amdgcn_mfma_f32_32x32x16_bf16(kb, q, sB, 0, 0, 0);
                }
            }
            float SC = SCL, off = 0.f;
            const int rel0 = pq - (u.kpos0 + 64 * t) - 4 * hi;
            if (MODE == 1) {
                if (aug) off = slope2 * (float)(pq - (u.kpos0 + 64 * t));
                else { const float bf = (float)rel0; SC = 1.0f;
#pragma unroll
                    for (int r = 0; r < 16; ++r) { const float c = (float)((r & 3) + 8 * (r >> 2));
                        sA[r] = sA[r] * SCL - slope2 * __builtin_fabsf(bf - c); sB[r] = sB[r] * SCL - slope2 * __builtin_fabsf(bf - c - 32.0f); }
                }
            } else if (MODE == 0) {
                const int wmin = (u.qpos0 + qg * 32) - (u.kpos0 + 64 * t + 63);
                if (wmin >= 128) off = -rb[256] * LOG2E;
                else { SC = 1.0f;
#pragma unroll
                    for (int r = 0; r < 16; ++r) { const int c = (r & 3) + 8 * (r >> 2);
                        int ra = rel0 - c, rbb = rel0 - c - 32; ra = ra < -128 ? -128 : (ra > 128 ? 128 : ra); rbb = rbb < -128 ? -128 : (rbb > 128 ? 128 : rbb);
                        sA[r] = sA[r] * SCL + rb[ra + 128] * LOG2E; sB[r] = sB[r] * SCL + rb[rbb + 128] * LOG2E; }
                }
            }
            if (64 * (t + 1) > u.nkeys) {
                const int k0 = 64 * t + 4 * hi;
#pragma unroll
                for (int r = 0; r < 16; ++r) { const int c = (r & 3) + 8 * (r >> 2); if (k0 + c >= u.nkeys) sA[r] = -INFINITY; if (k0 + c + 32 >= u.nkeys) sB[r] = -INFINITY; }
            }
            float mxa = __builtin_fmaxf(__builtin_fmaxf(sA[0], sA[1]), sB[0]), mxb = __builtin_fmaxf(__builtin_fmaxf(sA[2], sA[3]), sB[1]);
            mxa = __builtin_fmaxf(__builtin_fmaxf(mxa, sB[2]), sB[3]);
#pragma unroll
            for (int r = 4; r < 16; r += 4) { mxa = __builtin_fmaxf(__builtin_fmaxf(mxa, sA[r]), sA[r + 1]); mxb = __builtin_fmaxf(__builtin_fmaxf(mxb, sA[r + 2]), sA[r + 3]);
                mxa = __builtin_fmaxf(__builtin_fmaxf(mxa, sB[r]), sB[r + 1]); mxb = __builtin_fmaxf(__builtin_fmaxf(mxb, sB[r + 2]), sB[r + 3]); }
            float mx = __builtin_fmaxf(mxa, mxb);
            mx = __builtin_fmaxf(mx, __shfl_xor(mx, 32));
            const float smax = mx * SC - off;
            if (__any(smax > m_run + THR)) {
                const float m_new = __builtin_fmaxf(m_run, smax);
                const float alpha = __builtin_amdgcn_exp2f(m_run - m_new);
                m_run = m_new; l_run *= alpha;
#pragma unroll
                for (int db = 0; db < NDB; ++db)
#pragma unroll
                    for (int r = 0; r < 16; ++r) o[db][r] *= alpha;
            }
            const float cs = -(off + m_run);
            float rs0 = 0.f, rs1 = 0.f;
#pragma unroll
            for (int r = 0; r < 16; ++r) { sA[r] = __builtin_amdgcn_exp2f(__builtin_fmaf(sA[r], SC, cs)); sB[r] = __builtin_amdgcn_exp2f(__builtin_fmaf(sB[r], SC, cs)); rs0 += sA[r]; rs1 += sB[r]; }
            l_run += rs0 + rs1;
            u32x4 pa0, pa1, pb0, pb1;
            pa0.x = cvt_pk_bf16(sA[0], sA[1]); pa0.y = cvt_pk_bf16(sA[2], sA[3]); pa0.z = cvt_pk_bf16(sA[4], sA[5]); pa0.w = cvt_pk_bf16(sA[6], sA[7]);
            pa1.x = cvt_pk_bf16(sA[8], sA[9]); pa1.y = cvt_pk_bf16(sA[10], sA[11]); pa1.z = cvt_pk_bf16(sA[12], sA[13]); pa1.w = cvt_pk_bf16(sA[14], sA[15]);
            pb0.x = cvt_pk_bf16(sB[0], sB[1]); pb0.y = cvt_pk_bf16(sB[2], sB[3]); pb0.z = cvt_pk_bf16(sB[4], sB[5]); pb0.w = cvt_pk_bf16(sB[6], sB[7]);
            pb1.x = cvt_pk_bf16(sB[8], sB[9]); pb1.y = cvt_pk_bf16(sB[10], sB[11]); pb1.z = cvt_pk_bf16(sB[12], sB[13]); pb1.w = cvt_pk_bf16(sB[14], sB[15]);
#pragma unroll
            for (int db = 0; db < NDB; ++db) {
                const LAS unsigned char* vrow = cur + VOFFB + (voff + db * 32 + r32) * VSTRB + hi * 8 + sub * 128;
#define ATT_VF(base) ({ const s16x4 lo_ = *(const LAS s16x4*)(vrow + (base) * 2), hi_ = *(const LAS s16x4*)(vrow + ((base) + 8) * 2); (bf16x8){lo_[0], lo_[1], lo_[2], lo_[3], hi_[0], hi_[1], hi_[2], hi_[3]}; })
                o[db] = __builtin_amdgcn_mfma_f32_32x32x16_bf16(ATT_VF(0), __builtin_bit_cast(bf16x8, pa0), o[db], 0, 0, 0);
                o[db] = __builtin_amdgcn_mfma_f32_32x32x16_bf16(ATT_VF(16), __builtin_bit_cast(bf16x8, pa1), o[db], 0, 0, 0);
                o[db] = __builtin_amdgcn_mfma_f32_32x32x16_bf16(ATT_VF(32), __builtin_bit_cast(bf16x8, pb0), o[db], 0, 0, 0);
                o[db] = __builtin_amdgcn_mfma_f32_32x32x16_bf16(ATT_VF(48), __builtin_bit_cast(bf16x8, pb1), o[db], 0, 0, 0);
#undef ATT_VF
                if (F32) __builtin_amdgcn_sched_barrier(0);
            }
        }
        }
        if (F32 && j + 2 < nt) ATT_LOAD(t0 - 2 * NSUB);
        __syncthreads();
    }
#undef ATT_LOAD
#undef ATT_WRITE
    const float l_tot = l_run + __shfl_xor(l_run, 32);
    const float linv = 1.0f / l_tot;
    if (MODE != 1) {
        if (active && qrow < u.nq) {
            bf16_t* op = u.O + (size_t)qrow * u.ldo + ((MODE == 0) ? s * 64 : s * 128) + 4 * hi;
#pragma unroll
            for (int db = 0; db < NDB; ++db)
#pragma unroll
                for (int g = 0; g < 4; ++g) { u32x2 w; w.x = cvt_pk_bf16(o[db][4 * g] * linv, o[db][4 * g + 1] * linv); w.y = cvt_pk_bf16(o[db][4 * g + 2] * linv, o[db][4 * g + 3] * linv);
                    *(u32x2*)(op + db * 32 + 8 * g) = w; }
        }
    } else {
        LAS float* X = (LAS float*)lds + (size_t)qg * 64 * 64 + lane;
        if (s == 1 && active) {
#pragma unroll
            for (int db = 0; db < NDB; ++db)
#pragma unroll
                for (int r = 0; r < 16; ++r) X[(db * 16 + r) * 64] = o[db][r] * linv;
        }
        __syncthreads();
        if (s == 0 && active) {
            float ss = 0.f;
#pragma unroll
            for (int db = 0; db < NDB; ++db)
#pragma unroll
                for (int r = 0; r < 16; ++r) { const float v = o[db][r] * linv - lam * X[(db * 16 + r) * 64]; o[db][r] = v; ss += v * v; }
            ss += __shfl_xor(ss, 32);
            const float rstd = 0.8f / sqrtf(ss * (1.0f / 128.0f) + EPS);
            if (qrow < u.nq) {
                bf16_t* op = u.O + (size_t)qrow * u.ldo + 4 * hi;
#pragma unroll
                for (int db = 0; db < NDB; ++db)
#pragma unroll
                    for (int g = 0; g < 4; ++g) { const f32x4 sg = *(const f32x4*)(subg + db * 32 + 8 * g + 4 * hi);
                        u32x2 w; w.x = cvt_pk_bf16(o[db][4 * g] * rstd * sg[0], o[db][4 * g + 1] * rstd * sg[1]); w.y = cvt_pk_bf16(o[db][4 * g + 2] * rstd * sg[2], o[db][4 * g + 3] * rstd * sg[3]);
                        *(u32x2*)(op + db * 32 + 8 * g) = w; }
            }
        }
    }
}

__global__ void __launch_bounds__(512, 2) fwd_kernel(Args args) {
    extern __shared__ __attribute__((aligned(16))) unsigned char lds_raw[];
    LAS unsigned char* lds = (LAS unsigned char*)lds_raw;
    cg::grid_group grid = cg::this_grid();
    const int tid = threadIdx.x, lane = tid & 63, wave = __builtin_amdgcn_readfirstlane(tid >> 6);
    const int G = gridDim.x, bx = blockIdx.x;
    const int gw = bx * 8 + wave, NGW = G * 8;
    const int sw0 = wave * G + bx;
    unsigned char* ws = args.ws; float* out = args.out;
    unsigned* ctl = (unsigned*)(ws + WS_CTL);
#define x_p (args.in[0])
#define x_s (args.in[1])
#define cak (args.in[2])
#define cav (args.in[3])
#define cbk (args.in[4])
#define cbv (args.in[5])
#define cmk (args.in[6])
#define cmv (args.in[7])
#define memp (args.in[8])
#define b_gate (args.in[11])
#define rel_bias (args.in[12])
#define lam_qk (args.in[13])
#define subln (args.in[14])
#define ng (args.in[21])
#define W_UP1 ((bf16_t*)(ws + WS_UP1))
#define W_DN1 ((bf16_t*)(ws + WS_DN1))
#define W_ING ((bf16_t*)(ws + WS_ING))
#define W_BRA ((bf16_t*)(ws + WS_BRA))
#define W_BRB ((bf16_t*)(ws + WS_BRB))
#define W_OUT ((bf16_t*)(ws + WS_OUT))
#define W_MQ ((bf16_t*)(ws + WS_MQ))
#define W_MKV ((bf16_t*)(ws + WS_MKV))
#define W_MO ((bf16_t*)(ws + WS_MO))
#define W_UP2 ((bf16_t*)(ws + WS_UP2))
#define W_DN2 ((bf16_t*)(ws + WS_DN2))
#define MKB ((bf16_t*)(ws + WS_MKB))
#define MEMN ((bf16_t*)(ws + WS_MEMN))
#define XN ((bf16_t*)(ws + WS_XN))
#define ACT ((bf16_t*)(ws + WS_ACT))
#define DF ((float*)(ws + WS_DF))
#define H ((bf16_t*)(ws + WS_H))
#define DFB ((bf16_t*)(ws + WS_DF))
#define QKV ((bf16_t*)(ws + WS_QKV))
#define GATES ((bf16_t*)(ws + WS_GATES))
#define YA ((bf16_t*)(ws + WS_YA))
#define YB ((bf16_t*)(ws + WS_YB))
#define MKS ((bf16_t*)(ws + WS_MKS))
#define QM QKV
#define OM ACT
#define VTA ACT
#define VTB (ACT + (size_t)NB * 512 * SEQ)
    const int lo = args.ph_lo, hi_ph = args.ph_hi;
#ifndef PH_MASK
#define PH_MASK 0xffffffffu
#endif
#define IN(k) ((((PH_MASK) >> (k)) & 1u) && lo <= (k) && (k) < hi_ph)
#define SEAM(k) do { if (IN(k) && IN((k) + 1)) grid.sync(); } while (0)
#define GEMM_PHASE(EPI, e, Aptr, Bptr, Mrows, Ncols, Kdim, cidx) do { pg8::Gemm g_{(const pg8::bf16_t*)(Aptr), (const pg8::bf16_t*)(Bptr), (Mrows), (Ncols), (Kdim)}; pg8::StaticOrder S_; S_.init((Mrows), (Ncols), G, (cidx)); \
        pg8::gemm_phase<EPI, pg8::StaticOrder, true, true>(lds, g_, S_, e); if (REPG > 1) { __syncthreads(); pg8::gemm_phase<EPI, pg8::StaticOrder, true, true>(lds, g_, S_, e); } } while (0)

    if (IN(0)) for (int repb = 0; repb < REPB; ++repb) {
        if (bx == 0 && tid < 64 && repb == 0) ctl[tid] = 0u;
        LAS float* scr = (LAS float*)(lds + wave * 16384);
        constexpr int I_UP = 16 * (NUP / 32), I_DN = (DFF / 64) * 32, I_IN = 16 * (NIN / 32), I_GT = 16 * (NGATE / 32), I_BR = 8 * 32, I_SQ = 16 * 32, I_MKV = 16 * 64;
        constexpr int NITEMS = 2 * I_UP + 2 * I_DN + I_IN + I_GT + 2 * I_BR + 3 * I_SQ + I_MKV;
        for (int it = gw; it < NITEMS; it += NGW) {
            int r = it;
            if (r < I_UP) { transpose_item<true>(args.in[22], DM, NUP, W_UP1, 0, scr, r, lane); continue; } r -= I_UP;
            if (r < I_UP) { transpose_item<true>(args.in[24], DM, NUP, W_UP2, 0, scr, r, lane); continue; } r -= I_UP;
            if (r < I_DN) { transpose_item<false>(args.in[23], DFF, DM, W_DN1, 0, scr, r, lane); continue; } r -= I_DN;
            if (r < I_DN) { transpose_item<false>(args.in[25], DFF, DM, W_DN2, 0, scr, r, lane); continue; } r -= I_DN;
            if (r < I_IN) { transpose_item<false>(args.in[9], DM, NIN, W_ING, 0, scr, r, lane); continue; } r -= I_IN;
            if (r < I_GT) { transpose_item<false>(args.in[10], DM, NGATE, W_ING, NIN, scr, r, lane); continue; } r -= I_GT;
            if (r < I_BR) { transpose_item<false>(args.in[15], 512, DM, W_BRA, 0, scr, r, lane); continue; } r -= I_BR;
            if (r < I_BR) { transpose_item<false>(args.in[16], 512, DM, W_BRB, 0, scr, r, lane); continue; } r -= I_BR;
            if (r < I_SQ) { transpose_item<false>(args.in[17], DM, DM, W_OUT, 0, scr, r, lane); continue; } r -= I_SQ;
            if (r < I_SQ) { transpose_item<false>(args.in[18], DM, DM, W_MQ, 0, scr, r, lane); continue; } r -= I_SQ;
            if (r < I_SQ) { transpose_item<false>(args.in[20], DM, DM, W_MO, 0, scr, r, lane); continue; } r -= I_SQ;
            transpose_item<false>(args.in[19], DM, 2 * DM, W_MKV, 0, scr, r, lane);
        }
        for (int m = gw; m < MT + NB * MEMT; m += NGW) {
            if (m < MP) rms_row_to_bf16(x_p + (size_t)m * DM, ng, XN + (size_t)m * DM, lane);
            else if (m < MT) rms_row_to_bf16(x_s + (size_t)(m - MP) * DM, ng, XN + (size_t)m * DM, lane);
            else rms_row_to_bf16(memp + (size_t)(m - MT) * DM, ng + 6 * DM, MEMN + (size_t)(m - MT) * DM, lane);
        }
        for (int r = gw; r < 2 * DB * MEMT; r += NGW) {
            const int which = r / (DB * MEMT), rr = r % (DB * MEMT);
            const f32x4* src = (const f32x4*)((which ? cmv : cmk) + (size_t)rr * DM) + lane; u32x2* dst = (u32x2*)(MKS + (size_t)rr * 2048 + which * DM) + lane;
#pragma unroll
            for (int j = 0; j < 4; ++j) { const f32x4 v = src[64 * j]; u32x2 w; w.x = cvt_pk_bf16(v.x, v.y); w.y = cvt_pk_bf16(v.z, v.w); dst[64 * j] = w; }
        }
        for (int r = gw; r < 2 * DB * (LA - DS); r += NGW) {
            const int which = r / (DB * (LA - DS)), rr = r % (DB * (LA - DS)), n = rr / (LA - DS), j = rr % (LA - DS);
            const f32x4* src = (const f32x4*)((which ? cav : cak) + ((size_t)n * LA + j + DS) * 512) + lane;
            f32x4* dst = (f32x4*)(out + (which ? O_AVS : O_AKS) + ((size_t)n * LA + j) * 512) + lane;
            dst[0] = src[0]; dst[64] = src[64];
        }
    }
    SEAM(0);
    if (IN(1)) {
        { SSwiglu f{ACT + (size_t)MP * DFF}; small_gemm<DM>(lds, XN + (size_t)MP * DM, W_UP1, NUP / 64, true, bx, G, wave, lane, f); }
        { SMemKV f{out, MKB}; small_gemm<DM>(lds, MEMN, W_MKV, 2 * DM / 64, false, (bx + G / 2) % G, G, wave, lane, f);   }
        { EpiSwiglu e{ACT}; GEMM_PHASE(EpiSwiglu, e, XN, W_UP1, MP, NUP, DM, bx); }
    }
    SEAM(1);
    if (IN(2)) { { SBf16 f{DFB + (size_t)MP * DM, DM}; small_gemm<DFF>(lds, ACT + (size_t)MP * DFF, W_DN1, DM / 64, false, bx, G, wave, lane, f); }
        EpiBf16 e{DFB, DM}; GEMM_PHASE(EpiBf16, e, ACT, W_DN1, MP, DM, DFF, bx); }
    SEAM(2);
    if (IN(3)) for (int repb = 0; repb < REPB; ++repb) {
        for (int m = gw; m < MT; m += NGW) res_row<true, false>(m < MP ? x_p + (size_t)m * DM : x_s + (size_t)(m - MP) * DM, DFB + (size_t)m * DM, ng + 1 * DM, 0.5f, nullptr, H + (size_t)m * DM, ng + 2 * DM, XN + (size_t)m * DM, lane);
    }
    SEAM(3);
    if (IN(4)) { { SInGate f{QKV + (size_t)MP * NIN, GATES + (size_t)MP * NGATE, b_gate, out}; small_gemm<DM>(lds, XN + (size_t)MP * DM, W_ING, NING / 64, false, bx, G, wave, lane, f); }
        EpiInGate e{QKV, GATES, b_gate, out, VTA, VTB}; GEMM_PHASE(EpiInGate, e, XN, W_ING, MP, NING, DM, bx); }
    SEAM(4);
    if (IN(5)) {
        float lam;
        { const float a = lam_qk[lane] * lam_qk[64 + lane], b = lam_qk[128 + lane] * lam_qk[192 + lane]; lam = expf(wave_sum(a)) - expf(wave_sum(b)) + 0.2f; }
        constexpr int N_SD = DB * 4, N_SB = DB * 4, N_PD = NB * 4 * 128, N_PB = NB * 4 * 128;
        volatile LAS unsigned* qw = (volatile LAS unsigned*)(lds + LDS_QW);
#ifndef REP5
#define REP5 1
#endif
        for (int rep = 0; rep < REP5; ++rep) {
        for (;;) {
            __syncthreads();
            if (tid == 0) qw[0] = atomicAdd(&ctl[4 + 2 * rep], 1u);
            __syncthreads();
            const int idx = __builtin_amdgcn_readfirstlane((int)qw[0]);
            if (idx >= N_SD + N_SB) break;
            AUnit u;
            if (idx < N_SD) {
                const int n = idx >> 2, h = idx & 3; const size_t row0 = MP + (size_t)n * DS;
                u.Q = QKV + row0 * NIN + 1536 + h * 128; u.ldq = NIN; u.nq = DS; u.qpos0 = PAST;
                u.K0 = cbk + (size_t)n * PAST * 512 + h * 128; u.V0 = cbv + (size_t)n * PAST * 512 + h * 128; u.ld0 = 512; u.nt0 = PAST / 64;
                u.K1 = out + O_BKS + (size_t)n * DS * 512 + h * 128; u.V1 = out + O_BVS + (size_t)n * DS * 512 + h * 128; u.ld1 = 512; u.ldv1 = 0; u.n1 = DS;
                u.kpos0 = 0; u.tb = 0; u.te = PAST / 64 + 1; u.nkeys = PAST + DS; u.head = h; u.O = YB + row0 * 512 + h * 128; u.ldo = 512;
                attn_unit<1, true>(lds, u, lam, rel_bias, subln);
            } else {
                const int j = idx - N_SD, n = j >> 2, hp = j & 3; const size_t row0 = MP + (size_t)n * DS;
                u.Q = QKV + row0 * NIN + hp * 128; u.ldq = NIN; u.nq = DS; u.qpos0 = PAST;
                u.K0 = cak + (size_t)n * LA * 512 + hp * 128; u.V0 = cav + (size_t)n * LA * 512 + hp * 128; u.ld0 = 512; u.nt0 = LA / 64;
                u.K1 = out + O_AKS + ((size_t)n * LA + (LA - DS)) * 512 + hp * 128; u.V1 = out + O_AVS + ((size_t)n * LA + (LA - DS)) * 512 + hp * 128; u.ld1 = 512; u.ldv1 = 0; u.n1 = DS;
                u.kpos0 = PAST - LA; u.tb = 1; u.te = LA / 64 + 1; u.nkeys = LA + DS; u.head = 2 * hp; u.O = YA + row0 * 512 + hp * 128; u.ldo = 512;
                attn_unit<0, true>(lds, u, lam, rel_bias, subln);
            }
        }
        for (;;) {
            __syncthreads();
            if (tid == 0) { unsigned got = 0xffffffffu; for (int k = 0; k < 8; ++k) { const unsigned q = (unsigned)(bx + k) & 7u; const unsigned v = atomicAdd(&ctl[16 + q], 1u); if (v < 256u) { got = (q << 8) | v; break; } } qw[0] = got; }
            __syncthreads();
            const int idxq = __builtin_amdgcn_readfirstlane((int)qw[0]);
            if (idxq < 0) break;
            const int xq = idxq >> 8, idx = idxq & 255;
            AUnit u;
            if (idx < 128) {
                const int qb = 127 - idx, n = xq >> 2, h = xq & 3; const size_t row0 = (size_t)n * SEQ + 128 * qb;
                u.Q = QKV + row0 * NIN + 1536 + h * 128; u.ldq = NIN; u.nq = 128; u.qpos0 = 128 * qb;
                u.K0 = nullptr; u.V0 = nullptr; u.ld0 = 0; u.nt0 = 0;
                u.K1 = QKV + (size_t)n * SEQ * NIN + 2048 + h * 128; u.V1 = VTB + ((size_t)n * 512 + h * 128) * SEQ; u.ld1 = NIN; u.ldv1 = SEQ; u.n1 = 0x7fffffff;
                u.kpos0 = 0; u.tb = 0; u.te = 2 * qb + 2; u.nkeys = 0x7fffffff; u.head = h; u.O = YB + row0 * 512 + h * 128; u.ldo = 512;
                attn_unit<1, false>(lds, u, lam, rel_bias, subln);
            } else {
                const int qb = 255 - idx, n = xq >> 2, hp = xq & 3; const size_t row0 = (size_t)n * SEQ + 128 * qb;
                u.Q = QKV + row0 * NIN + hp * 128; u.ldq = NIN; u.nq = 128; u.qpos0 = 128 * qb;
                u.K0 = nullptr; u.V0 = nullptr; u.ld0 = 0; u.nt0 = 0;
                u.K1 = QKV + (size_t)n * SEQ * NIN + 512 + hp * 128; u.V1 = VTA + ((size_t)n * 512 + hp * 128) * SEQ; u.ld1 = NIN; u.ldv1 = SEQ; u.n1 = 0x7fffffff;
                u.kpos0 = 0; u.tb = (2 * qb - 8 > 0) ? 2 * qb - 8 : 0; u.te = 2 * qb + 2; u.nkeys = 0x7fffffff; u.head = 2 * hp; u.O = YA + row0 * 512 + hp * 128; u.ldo = 512;
                attn_unit<0, false>(lds, u, lam, rel_bias, subln);
            }
        }
        }
    }
    SEAM(5);
    if (IN(6)) { { SBrA f{GATES + (size_t)MP * NGATE, DF + (size_t)MP * DM}; small_gemm<512>(lds, YA + (size_t)MP * 512, W_BRA, DM / 64, false, bx, G, wave, lane, f); }
        EpiBrA e{GATES, DF}; GEMM_PHASE(EpiBrA, e, YA, W_BRA, MP, DM, 512, bx); }
    SEAM(6);
    if (IN(7)) { { SBrB f{GATES + (size_t)MP * NGATE, DF + (size_t)MP * DM, XN + (size_t)MP * DM}; small_gemm<512>(lds, YB + (size_t)MP * 512, W_BRB, DM / 64, false, bx, G, wave, lane, f); }
        EpiBrB e{GATES, DF, XN}; GEMM_PHASE(EpiBrB, e, YB, W_BRB, MP, DM, 512, bx); }
    SEAM(7);
    if (IN(8)) { { SBf16 f{DFB + (size_t)MP * DM, DM}; small_gemm<DM>(lds, XN + (size_t)MP * DM, W_OUT, DM / 64, false, bx, G, wave, lane, f); }
        EpiBf16 e{DFB, DM}; GEMM_PHASE(EpiBf16, e, XN, W_OUT, MP, DM, DM, bx); }
    SEAM(8);
    if (IN(9)) { for (int m = gw; m < MT; m += NGW) res_row<false, false>(H + (size_t)m * DM, DFB + (size_t)m * DM, ng + 3 * DM, 1.0f, nullptr, H + (size_t)m * DM, ng + 4 * DM, XN + (size_t)m * DM, lane); }
    SEAM(9);
    if (IN(10)) { { SBf16 f{QM + (size_t)MP * DM, DM}; small_gemm<DM>(lds, XN + (size_t)MP * DM, W_MQ, DM / 64, false, bx, G, wave, lane, f); }
        EpiBf16 e{QM, DM}; GEMM_PHASE(EpiBf16, e, XN, W_MQ, MP, DM, DM, bx); }
    SEAM(10);
    if (IN(11)) {
        constexpr int N_S = DB * 4, N_P = NB * 4 * 128, N_ALL = N_S + N_P;
        volatile LAS unsigned* qw = (volatile LAS unsigned*)(lds + LDS_QW);
#ifndef REP11
#define REP11 1
#endif
        for (int rep = 0; rep < REP11; ++rep)
        for (;;) {
            __syncthreads();
            if (tid == 0) qw[0] = atomicAdd(&ctl[1 + 16 * rep], 1u);
            __syncthreads();
            const int idx = __builtin_amdgcn_readfirstlane((int)qw[0]);
            if (idx >= N_ALL) break;
            AUnit u; u.ldv1 = 0; u.qpos0 = 0; u.kpos0 = 0; u.tb = 0; u.te = MEMT / 64; u.nkeys = 0x7fffffff; u.ldq = DM; u.ldo = DM;
            if (idx < N_S) {
                const int n = idx >> 2, h = idx & 3; const size_t row0 = MP + (size_t)n * DS;
                u.Q = QM + row0 * DM + h * 256; u.nq = DS; u.head = h;
                u.K0 = nullptr; u.V0 = nullptr; u.ld0 = 0; u.nt0 = 0;
                u.K1 = MKS + (size_t)n * MEMT * 2048 + h * 256; u.V1 = MKS + (size_t)n * MEMT * 2048 + DM + h * 256; u.ld1 = 2048; u.n1 = 0x7fffffff; u.O = OM + row0 * DM + h * 256;
                attn_unit<2, false>(lds, u, 0.f, rel_bias, subln);
            } else {
                const int j = idx - N_S, qb = j >> 3, n = (j >> 2) & 1, h = j & 3; const size_t row0 = (size_t)n * SEQ + 128 * qb;
                u.Q = QM + row0 * DM + h * 256; u.nq = 128; u.head = h;
                u.K0 = nullptr; u.V0 = nullptr; u.ld0 = 0; u.nt0 = 0;
                u.K1 = MKB + (size_t)n * MEMT * 2048 + h * 256; u.V1 = MKB + (size_t)n * MEMT * 2048 + DM + h * 256; u.ld1 = 2048; u.n1 = 0x7fffffff; u.O = OM + row0 * DM + h * 256;
                attn_unit<2, false>(lds, u, 0.f, rel_bias, subln);
            }
        }
    }
    SEAM(11);
    if (IN(12)) { { SBf16 f{DFB + (size_t)MP * DM, DM}; small_gemm<DM>(lds, OM + (size_t)MP * DM, W_MO, DM / 64, false, bx, G, wave, lane, f); }
        EpiBf16 e{DFB, DM}; GEMM_PHASE(EpiBf16, e, OM, W_MO, MP, DM, DM, bx); }
    SEAM(12);
    if (IN(13)) { for (int m = gw; m < MT; m += NGW) res_row<false, false>(H + (size_t)m * DM, DFB + (size_t)m * DM, ng + 5 * DM, 1.0f, nullptr, H + (size_t)m * DM, ng + 7 * DM, XN + (size_t)m * DM, lane); }
    SEAM(13);
    if (IN(14)) { { SSwiglu f{ACT + (size_t)MP * DFF}; small_gemm<DM>(lds, XN + (size_t)MP * DM, W_UP2, NUP / 64, true, bx, G, wave, lane, f); }
        EpiSwiglu e{ACT}; GEMM_PHASE(EpiSwiglu, e, XN, W_UP2, MP, NUP, DM, bx); }
    SEAM(14);
    if (IN(15)) { { SBf16 f{DFB + (size_t)MP * DM, DM}; small_gemm<DFF>(lds, ACT + (size_t)MP * DFF, W_DN2, DM / 64, false, bx, G, wave, lane, f); }
        EpiBf16 e{DFB, DM}; GEMM_PHASE(EpiBf16, e, ACT, W_DN2, MP, DM, DFF, bx); }
    SEAM(15);
    if (IN(16)) for (int repb = 0; repb < REPB; ++repb) { for (int m = gw; m < MT; m += NGW) res_row<false, true>(H + (size_t)m * DM, DFB + (size_t)m * DM, ng + 8 * DM, 0.5f, out + O_YP + (size_t)m * DM, nullptr, nullptr, nullptr, lane); }
#undef IN
#undef SEAM
#undef GEMM_PHASE
}
constexpr int N_PHASES = 17;

extern "C" void kernel_launch(void* const* d_in, const int* in_sizes, int n_in, void* d_out, int out_size, void* d_ws, size_t ws_size, hipStream_t stream) {
    static int grid = 0;
    if (grid == 0) {
        if (n_in != 26 || (size_t)out_size != O_END || ws_size < WS_END) { fprintf(stderr, "kernel_launch: unexpected shapes: n_in %d out %d (want %zu) ws %zu (want %zu)\n", n_in, out_size, (size_t)O_END, ws_size, (size_t)WS_END); grid = -1; return; }
        int dev = 0, cus = 0, per_cu = 0;
        hipGetDevice(&dev); hipDeviceGetAttribute(&cus, hipDeviceAttributeMultiprocessorCount, dev);
        if (hipFuncSetAttribute((const void*)fwd_kernel, hipFuncAttributeMaxDynamicSharedMemorySize, LDS_BYTES) != hipSuccess) { fprintf(stderr, "kernel_launch: hipFuncSetAttribute failed\n"); grid = -1; return; }
        if (hipOccupancyMaxActiveBlocksPerMultiprocessor(&per_cu, (const void*)fwd_kernel, 512, LDS_BYTES) != hipSuccess || per_cu < 1) { fprintf(stderr, "kernel_launch: occupancy query says %d\n", per_cu); per_cu = 1; }
        (void)hipGetLastError();
        grid = cus * 1;
        if (grid <= 0) grid = 256;
    }
    if (grid < 0) return;
    (void)hipMemsetAsync((char*)d_ws + WS_CTL, 0, 4096, stream);
    Args a{};
    for (int i = 0; i < 26; ++i) a.in[i] = (const float*)d_in[i];
    a.out = (float*)d_out; a.ws = (unsigned char*)d_ws;
#if MK_MULTI
    for (int p = 0; p < N_PHASES; ++p) { a.ph_lo = p; a.ph_hi = p + 1; hipLaunchKernelGGL(fwd_kernel, dim3(grid), dim3(512), LDS_BYTES, stream, a); }
#else
    a.ph_lo = 0; a.ph_hi = N_PHASES;
    void* kargs[] = {&a};
    hipError_t e = hipLaunchCooperativeKernel((const void*)fwd_kernel, dim3(grid), dim3(512), kargs, LDS_BYTES, stream);
    if (e != hipSuccess) fprintf(stderr, "kernel_launch: cooperative launch failed: %s (grid %d)\n", hipGetErrorString(e), grid);
#endif
}
```
